# Optimizing an MI355X kernel written in HIP

```python
import jax, jax.numpy as jnp
from jax import lax
import numpy as np

D_MODEL = 1024
BATCH = 4
SEQ = 4096
DEPTH = 2
DEC_BATCH = 128
DEC_SEQ = 1
PAST_LEN = 16384
PAGE_SIZE = 128

HEAD_DIM = 64
MIX_WIDTH = 384
N_GROUPS = MIX_WIDTH // HEAD_DIM
N_BRANCH = 4
CONV_WIDTH = 3
SWA_WINDOW = 128
SWA_Q_HEADS = 6
SWA_KV_HEADS = 2
SWA_REP = SWA_Q_HEADS // SWA_KV_HEADS
CHUNK = 128
DIL_GROUPS = ((128, 1), (512, 4), (2048, 16))
DIL_HEADS = N_GROUPS // len(DIL_GROUPS)
BLOCK = 128
ROPE_THETA = 10000.0
EPS = 1e-6
NEG_INF = -1e30

SPLIT_SIZES = (MIX_WIDTH, MIX_WIDTH, MIX_WIDTH, MIX_WIDTH,
               SWA_Q_HEADS * HEAD_DIM, SWA_KV_HEADS * HEAD_DIM, SWA_KV_HEADS * HEAD_DIM, MIX_WIDTH,
               MIX_WIDTH, MIX_WIDTH, MIX_WIDTH,
               MIX_WIDTH, MIX_WIDTH, MIX_WIDTH, MIX_WIDTH)
IN_COLS = sum(SPLIT_SIZES)
SPLIT_POINTS = tuple(int(s) for s in np.cumsum(SPLIT_SIZES)[:-1])

kernel_name = "hybrid_parallel_gated_mixers_step"


def rms_norm(x, g):
    x32 = x.astype(jnp.float32)
    y = x32 * lax.rsqrt(jnp.mean(x32 * x32, axis=-1, keepdims=True) + EPS)
    return (y * g.astype(jnp.float32)).astype(x.dtype)


def layer_norm(x, g, b):
    x32 = x.astype(jnp.float32)
    mu = jnp.mean(x32, axis=-1, keepdims=True)
    var = jnp.mean(jnp.square(x32 - mu), axis=-1, keepdims=True)
    y = (x32 - mu) * lax.rsqrt(var + EPS)
    return (y * g.astype(jnp.float32) + b.astype(jnp.float32)).astype(x.dtype)


def silu(x):
    return x * jax.nn.sigmoid(x)


def rope(x, pos):
    half = x.shape[-1] // 2
    inv_freq = ROPE_THETA ** (-jnp.arange(half, dtype=jnp.float32) / half)
    ang = pos.astype(jnp.float32)[:, None] * inv_freq[None, :]
    cos = jnp.cos(ang)[:, None, :]
    sin = jnp.sin(ang)[:, None, :]
    x32 = x.astype(jnp.float32)
    x1, x2 = x32[..., :half], x32[..., half:]
    return jnp.concatenate([x1 * cos - x2 * sin, x2 * cos + x1 * sin], axis=-1).astype(x.dtype)


def masked_softmax(scores, mask, sink):
    s = jnp.where(mask, scores, jnp.float32(NEG_INF))
    m = jnp.max(s, axis=-1, keepdims=True)
    if sink is not None:
        m = jnp.maximum(m, sink)
    p = jnp.exp(s - m)
    den = jnp.sum(p, axis=-1, keepdims=True)
    if sink is not None:
        den = den + jnp.exp(sink - m)
    return p / den, (m + jnp.log(den))[..., 0]


def banded_window_attention(q, k, v, window, sink):
    Bn, L, Hkv, R, Dh = q.shape
    pad = (-L) % BLOCK
    Lp = L + pad
    nb = Lp // BLOCK

    def padseq(a):
        return jnp.pad(a, [(0, 0), (0, pad)] + [(0, 0)] * (a.ndim - 2))

    qb = padseq(q).reshape(Bn, nb, BLOCK, Hkv, R, Dh)
    kb = padseq(k).reshape(Bn, nb, BLOCK, Hkv, Dh)
    vb = padseq(v).reshape(Bn, nb, BLOCK, Hkv, Dh)
    kk = jnp.concatenate([jnp.concatenate([jnp.zeros_like(kb[:, :1]), kb[:, :-1]], axis=1), kb], axis=2)
    vv = jnp.concatenate([jnp.concatenate([jnp.zeros_like(vb[:, :1]), vb[:, :-1]], axis=1), vb], axis=2)
    scores = jnp.einsum('bnihrd,bnjhd->bnhrij', qb, kk, preferred_element_type=jnp.float32) * (Dh ** -0.5)
    i = jnp.arange(BLOCK)[:, None]
    j = jnp.arange(2 * BLOCK)[None, :]
    dist = i - j + BLOCK
    key_idx = jnp.arange(nb)[:, None, None] * BLOCK + j[None] - BLOCK
    mask = (dist >= 0)[None] & (dist <= window)[None] & (key_idx >= 0)
    mask = mask[None, :, None, None]
    sink_b = None if sink is None else sink.astype(jnp.float32)[None, None, :, :, None, None]
    p, lse = masked_softmax(scores, mask, sink_b)
    out = jnp.einsum('bnhrij,bnjhd->bnihrd', p.astype(v.dtype), vv).reshape(Bn, Lp, Hkv, R, Dh)[:, :L]
    lse = jnp.moveaxis(lse, -1, 2).reshape(Bn, Lp, Hkv, R)[:, :L]
    return out, lse


def gathered_window_attention(q, k_all, v_all, n_past, window, dilation, sink):
    S, Dh = q.shape[1], q.shape[-1]
    n_keys = window // dilation + 1
    idx = n_past + jnp.arange(S)[:, None] - dilation * jnp.arange(n_keys)[None, :]
    valid = idx >= 0
    idx = jnp.maximum(idx, 0)
    kg = k_all[:, idx]
    vg = v_all[:, idx]
    scores = jnp.einsum('bihrd,bikhd->bhrik', q, kg, preferred_element_type=jnp.float32) * (Dh ** -0.5)
    sink_b = None if sink is None else sink.astype(jnp.float32)[None, :, :, None, None]
    p, lse = masked_softmax(scores, valid[None, None, None], sink_b)
    out = jnp.einsum('bhrik,bikhd->bihrd', p.astype(v_all.dtype), vg)
    return out, jnp.moveaxis(lse, -1, 1)


def dilated_prompt_attention(q, k, v, window, dilation):
    Bn, S, H, Dh = q.shape
    L = S // dilation

    def split(a):
        return a.reshape(Bn, L, dilation, H, Dh).transpose(0, 2, 1, 3, 4).reshape(Bn * dilation, L, H, Dh)

    out, lse = banded_window_attention(split(q)[:, :, :, None], split(k), split(v), window // dilation, None)
    out = out[:, :, :, 0].reshape(Bn, dilation, L, H, Dh).transpose(0, 2, 1, 3, 4).reshape(Bn, S, H, Dh)
    lse = lse[..., 0].reshape(Bn, dilation, L, H).transpose(0, 2, 1, 3).reshape(Bn, S, H)
    return out, lse


def chunk_spatial_mix(v, w_s, b_s):
    Bn, S, _ = v.shape
    pad = (-S) % CHUNK
    vp = jnp.pad(v, ((0, 0), (0, pad), (0, 0))).reshape(Bn, (S + pad) // CHUNK, CHUNK, N_GROUPS, HEAD_DIM)
    w_causal = jnp.where(jnp.tril(jnp.ones((CHUNK, CHUNK), dtype=bool))[None], w_s, 0).astype(v.dtype)
    mixed = jnp.einsum('gts,bcsgd->bctgd', w_causal, vp) + b_s.T.astype(v.dtype)[None, None, :, :, None]
    return mixed.reshape(Bn, S + pad, MIX_WIDTH)[:, :S]


def mixer_layer(x, pos, past, norm_g, w_in, conv_w, sinks, v_ln_g, v_ln_b, w_spatial, b_spatial,
                w_branch, w_merge, w_out):
    Bn, S, _ = x.shape
    h = rms_norm(x, norm_g)
    (a_b, a_c, a_h, a_gate, s_q, s_k, s_v, s_gate,
     c_u, c_v, c_gate, d_q, d_k, d_v, d_gate) = jnp.split(h @ w_in, SPLIT_POINTS, axis=-1)

    z = a_c * a_h
    prev = jnp.zeros((Bn, CONV_WIDTH - 1, MIX_WIDTH), z.dtype) if past is None else past[0]
    zp = jnp.concatenate([prev, z], axis=1)
    conv = sum(conv_w[t] * zp[:, t:t + S] for t in range(CONV_WIDTH))
    y_a = a_b * conv
    new_conv = zp[:, -(CONV_WIDTH - 1):]

    q = rope(s_q.reshape(Bn, S, SWA_Q_HEADS, HEAD_DIM), pos).reshape(Bn, S, SWA_KV_HEADS, SWA_REP, HEAD_DIM)
    k = rope(s_k.reshape(Bn, S, SWA_KV_HEADS, HEAD_DIM), pos)
    v = s_v.reshape(Bn, S, SWA_KV_HEADS, HEAD_DIM)
    sink = sinks.reshape(SWA_KV_HEADS, SWA_REP)
    if past is None:
        o_b, _ = banded_window_attention(q, k, v, SWA_WINDOW, sink)
        k_all, v_all, keep = k, v, min(SWA_WINDOW, S)
    else:
        n_past = past[1].shape[1]
        k_all = jnp.concatenate([past[1][:, :, 0], k], axis=1)
        v_all = jnp.concatenate([past[1][:, :, 1], v], axis=1)
        o_b, _ = gathered_window_attention(q, k_all, v_all, n_past, SWA_WINDOW, 1, sink)
        keep = n_past
    y_b = o_b.reshape(Bn, S, MIX_WIDTH)
    new_swa = jnp.stack([k_all[:, -keep:], v_all[:, -keep:]], axis=2)

    vn = layer_norm(c_v, v_ln_g, v_ln_b)
    y_c = c_u * chunk_spatial_mix(vn, w_spatial, b_spatial)

    dq = rope(d_q.reshape(Bn, S, N_GROUPS, HEAD_DIM), pos)
    dk = rope(d_k.reshape(Bn, S, N_GROUPS, HEAD_DIM), pos)
    dv = d_v.reshape(Bn, S, N_GROUPS, HEAD_DIM)
    outs, lses, new_dil = [], [], []
    for g, (win, dil) in enumerate(DIL_GROUPS):
        qg = dq[:, :, g * DIL_HEADS:(g + 1) * DIL_HEADS]
        kg = dk[:, :, g * DIL_HEADS:(g + 1) * DIL_HEADS]
        vg = dv[:, :, g * DIL_HEADS:(g + 1) * DIL_HEADS]
        if past is None:
            o, lse = dilated_prompt_attention(qg, kg, vg, win, dil)
            k_all, v_all, keep = kg, vg, min(win, S)
        else:
            buf = past[2][g]
            n_past = buf.shape[1]
            k_all = jnp.concatenate([buf[:, :, 0], kg], axis=1)
            v_all = jnp.concatenate([buf[:, :, 1], vg], axis=1)
            o, lse = gathered_window_attention(qg[:, :, :, None], k_all, v_all, n_past, win, dil, None)
            o, lse = o[:, :, :, 0], lse[..., 0]
            keep = n_past
        outs.append(o)
        lses.append(lse)
        new_dil.append(jnp.stack([k_all[:, -keep:], v_all[:, -keep:]], axis=2))
    alpha = jax.nn.softmax(jnp.stack(lses, axis=0), axis=0)
    y_d = jnp.concatenate([o * alpha[g][..., None].astype(o.dtype) for g, o in enumerate(outs)],
                          axis=2).reshape(Bn, S, MIX_WIDTH)

    branches = jnp.stack([y_a * silu(a_gate), y_b * silu(s_gate), y_c * silu(c_gate), y_d * silu(d_gate)], axis=2)
    proj_b = jnp.einsum('bsne,ned->bsnd', branches, w_branch)
    gates = jax.nn.sigmoid(h @ w_merge).reshape(Bn, S, N_BRANCH, D_MODEL)
    merged = jnp.sum(gates * proj_b, axis=2)
    return x + merged @ w_out, new_conv, new_swa, new_dil, vn


def setup_inputs(seed: int = 0) -> dict:
    key = jax.random.key(seed)
    ks = jax.random.split(key, 19)

    def nrm(k, shape, scale):
        return scale * jax.random.normal(k, shape, jnp.float32)

    n_swa = min(SWA_WINDOW, PAST_LEN)
    dil_rows = [min(w, PAST_LEN) for w, _ in DIL_GROUPS]
    return {
        "x_prompt": nrm(ks[0], (BATCH, SEQ, D_MODEL), 1.0),
        "x_sample": nrm(ks[1], (DEC_BATCH, DEC_SEQ, D_MODEL), 1.0),
        "state_conv": nrm(ks[2], (DEPTH, DEC_BATCH, CONV_WIDTH - 1, MIX_WIDTH), 0.5),
        "cache_swa_kv": nrm(ks[3], (DEPTH, DEC_BATCH, n_swa, 2, SWA_KV_HEADS, HEAD_DIM), 1.0),
        "cache_dil1_kv": nrm(ks[4], (DEPTH, DEC_BATCH, dil_rows[0], 2, DIL_HEADS, HEAD_DIM), 1.0),
        "cache_dil4_kv": nrm(ks[5], (DEPTH, DEC_BATCH, dil_rows[1], 2, DIL_HEADS, HEAD_DIM), 1.0),
        "cache_dil16_kv": nrm(ks[6], (DEPTH, DEC_BATCH, dil_rows[2], 2, DIL_HEADS, HEAD_DIM), 1.0),
        "norm_g": 1.0 + nrm(ks[7], (DEPTH, D_MODEL), 0.05),
        "w_in": nrm(ks[8], (DEPTH, D_MODEL, IN_COLS), D_MODEL ** -0.5),
        "conv_w": nrm(ks[9], (DEPTH, CONV_WIDTH, MIX_WIDTH), CONV_WIDTH ** -0.5),
        "attn_sinks": nrm(ks[10], (DEPTH, SWA_Q_HEADS), 1.0),
        "v_ln_g": 1.0 + nrm(ks[11], (DEPTH, MIX_WIDTH), 0.05),
        "v_ln_b": nrm(ks[12], (DEPTH, MIX_WIDTH), 0.02),
        "w_spatial": nrm(ks[13], (DEPTH, N_GROUPS, CHUNK, CHUNK), 0.5 * CHUNK ** -0.5),
        "b_spatial": 1.0 + nrm(ks[14], (DEPTH, N_GROUPS, CHUNK), 0.1),
        "w_branch": nrm(ks[15], (DEPTH, N_BRANCH, MIX_WIDTH, D_MODEL), MIX_WIDTH ** -0.5),
        "w_merge": nrm(ks[16], (DEPTH, D_MODEL, N_BRANCH * D_MODEL), D_MODEL ** -0.5),
        "w_out": nrm(ks[17], (DEPTH, D_MODEL, D_MODEL), D_MODEL ** -0.5),
        "final_norm_g": 1.0 + nrm(ks[18], (D_MODEL,), 0.05),
    }


def reference(x_prompt, x_sample, state_conv, cache_swa_kv, cache_dil1_kv, cache_dil4_kv, cache_dil16_kv,
              norm_g, w_in, conv_w, attn_sinks, v_ln_g, v_ln_b, w_spatial, b_spatial,
              w_branch, w_merge, w_out, final_norm_g):
    pos_prompt = jnp.arange(SEQ, dtype=jnp.int32)
    pos_sample = PAST_LEN + jnp.arange(DEC_SEQ, dtype=jnp.int32)
    xp, xs = x_prompt, x_sample
    conv_p, conv_s, swa_p, swa_s, chunk_v_s = [], [], [], [], []
    dil_p = [[] for _ in DIL_GROUPS]
    dil_s = [[] for _ in DIL_GROUPS]
    for l in range(DEPTH):
        lw = (norm_g[l], w_in[l], conv_w[l], attn_sinks[l], v_ln_g[l], v_ln_b[l],
              w_spatial[l], b_spatial[l], w_branch[l], w_merge[l], w_out[l])
        xp, c_p, s_p, d_p, _ = mixer_layer(xp, pos_prompt, None, *lw)
        past = (state_conv[l], cache_swa_kv[l], (cache_dil1_kv[l], cache_dil4_kv[l], cache_dil16_kv[l]))
        xs, c_s, s_s, d_s, v_s = mixer_layer(xs, pos_sample, past, *lw)
        conv_p.append(c_p)
        conv_s.append(c_s)
        swa_p.append(s_p)
        swa_s.append(s_s)
        chunk_v_s.append(v_s)
        for g in range(len(DIL_GROUPS)):
            dil_p[g].append(d_p[g])
            dil_s[g].append(d_s[g])
    y_prompt = rms_norm(xp, final_norm_g)
    y_sample = rms_norm(xs, final_norm_g)
    return (y_prompt, y_sample,
            jnp.stack(conv_p), jnp.stack(conv_s),
            jnp.stack(swa_p), jnp.stack(swa_s),
            jnp.stack(dil_p[0]), jnp.stack(dil_s[0]),
            jnp.stack(dil_p[1]), jnp.stack(dil_s[1]),
            jnp.stack(dil_p[2]), jnp.stack(dil_s[2]),
            jnp.stack(chunk_v_s))
```

```cpp
#include <hip/hip_runtime.h>
#include <cstdio>
#include <cstdint>

#define LAS __attribute__((address_space(3)))
#define GAS __attribute__((address_space(1)))
typedef unsigned short bf16_t;
typedef short bf16x8 __attribute__((ext_vector_type(8)));
typedef short s16x4 __attribute__((ext_vector_type(4)));
typedef float f32x4 __attribute__((ext_vector_type(4)));
typedef float f32x2 __attribute__((ext_vector_type(2)));
typedef float f32x16 __attribute__((ext_vector_type(16)));
typedef unsigned u32x4 __attribute__((ext_vector_type(4)));
typedef unsigned u32x2 __attribute__((ext_vector_type(2)));
typedef __bf16 bf16x2_t __attribute__((ext_vector_type(2)));

constexpr int DM = 1024, NBAT = 4, SEQ = 4096, DEPTH = 2, DB = 128, MIXW = 384;
constexpr int MP = NBAT * SEQ;
constexpr int MT = MP + DB;
constexpr int MPAD = 16640;
constexpr int INC = 5248, MRG = 4096, N1 = INC + MRG, N1PAD = 9472, NHB = N1 / 128;
constexpr int A_B = 0, A_C = 384, A_H = 768, A_G = 1152, S_Q = 1536, S_K = 1920, S_V = 2048, S_G = 2176,
              C_U = 2560, C_V = 2944, C_G = 3328, D_Q = 3712, D_K = 4096, D_V = 4480, D_G = 4864;
constexpr float EPS = 1e-6f;
constexpr float LOG2E = 1.4426950408889634f, LN2 = 0.6931471805599453f;

constexpr size_t O_Y = 0, O_YS = (size_t)MP * DM, O_CONVP = O_YS + (size_t)DB * DM, O_CONVS = O_CONVP + (size_t)DEPTH * NBAT * 2 * MIXW,
    O_SWAP = O_CONVS + (size_t)DEPTH * DB * 2 * MIXW, O_SWAS = O_SWAP + (size_t)DEPTH * NBAT * 128 * 256, O_D1P = O_SWAS + (size_t)DEPTH * DB * 128 * 256,
    O_D1S = O_D1P + (size_t)DEPTH * NBAT * 128 * 256, O_D4P = O_D1S + (size_t)DEPTH * DB * 128 * 256, O_D4S = O_D4P + (size_t)DEPTH * NBAT * 512 * 256,
    O_D16P = O_D4S + (size_t)DEPTH * DB * 512 * 256, O_D16S = O_D16P + (size_t)DEPTH * NBAT * 2048 * 256, O_CHV = O_D16S + (size_t)DEPTH * DB * 2048 * 256,
    O_END = O_CHV + (size_t)DEPTH * DB * MIXW;
static_assert(O_END == 207525888ull, "output size");

constexpr size_t al256(size_t x) { return (x + 255) & ~(size_t)255; }
constexpr size_t WS_CTL = 0, CTL_BYTES = 1u << 20;
constexpr size_t WS_W1T = CTL_BYTES, W1T_BYTES = (size_t)N1PAD * DM * 2;
constexpr size_t WS_WBT = WS_W1T + DEPTH * W1T_BYTES, WBT_BYTES = (size_t)4 * DM * MIXW * 2;
constexpr size_t WS_WOT = WS_WBT + DEPTH * WBT_BYTES, WOT_BYTES = (size_t)DM * DM * 2;
constexpr size_t WS_WSP = WS_WOT + DEPTH * WOT_BYTES, WSP_BYTES = (size_t)6 * 128 * 128 * 2;
constexpr size_t WS_COS = WS_WSP + DEPTH * WSP_BYTES, ROPE_BYTES = al256((size_t)4097 * 32 * 4);
constexpr size_t WS_SIN = WS_COS + ROPE_BYTES;
constexpr size_t WS_GUARD = WS_SIN + ROPE_BYTES;
constexpr size_t WS_P = WS_GUARD + (2u << 20), P_BYTES = (size_t)MPAD * INC * 2;
constexpr size_t WS_G = WS_P + P_BYTES, G_BYTES = (size_t)MPAD * MRG * 2;
constexpr size_t WS_XB = WS_G + G_BYTES, XB_BYTES = (size_t)MPAD * DM * 2;
constexpr size_t WS_X1 = WS_XB + XB_BYTES, X1_BYTES = (size_t)MPAD * DM * 4;
constexpr size_t WS_SSQ = WS_X1 + X1_BYTES, SSQ_BYTES = (size_t)MPAD * 16 * 4;
constexpr size_t WS_BR = WS_SSQ + SSQ_BYTES, BR1_BYTES = (size_t)MPAD * MIXW * 2;
constexpr size_t WS_LSE = WS_BR + 4 * BR1_BYTES, LSE_BYTES = (size_t)MPAD * 8 * 4;
constexpr size_t WS_MRG = WS_LSE + LSE_BYTES, MRGB_BYTES = (size_t)MPAD * DM * 2;
constexpr size_t WS_SCR = WS_MRG + MRGB_BYTES, SCR_BYTES = (size_t)256 * 65536 * 4;
constexpr size_t WS_END = WS_SCR + SCR_BYTES;

__device__ __forceinline__ float bf2f(unsigned short u) { return __uint_as_float((unsigned)u << 16); }
__device__ __forceinline__ float bflo(unsigned w) { return __uint_as_float(w << 16); }
__device__ __forceinline__ float bfhi(unsigned w) { return __uint_as_float(w & 0xffff0000u); }
__device__ __forceinline__ unsigned pk2(float lo, float hi) { f32x2 v = {lo, hi}; bf16x2_t b = __builtin_convertvector(v, bf16x2_t); return __builtin_bit_cast(unsigned, b); }
__device__ __forceinline__ float sigmoidf_(float x) { return __builtin_amdgcn_rcpf(1.0f + __builtin_amdgcn_exp2f(-x * LOG2E)); }
__device__ __forceinline__ float siluf_(float x) { return x * sigmoidf_(x); }
__device__ __forceinline__ float wave_sum(float v) {
#pragma unroll
    for (int o = 1; o < 64; o <<= 1) v += __shfl_xor(v, o);
    return v;
}
__device__ __forceinline__ float wave_max(float v) {
#pragma unroll
    for (int o = 1; o < 64; o <<= 1) v = fmaxf(v, __shfl_xor(v, o));
    return v;
}
__device__ __forceinline__ int crow(int r, int hi) { return (r & 3) + 8 * (r >> 2) + 4 * hi; }
__device__ __forceinline__ int fresh_lane() { int l; asm volatile("v_mbcnt_lo_u32_b32 %0, -1, 0\n\tv_mbcnt_hi_u32_b32 %0, -1, %0" : "=v"(l)); return l; }
#define LDS_WAIT() asm volatile("s_waitcnt lgkmcnt(0)" ::: "memory")
#define VM_WAIT() asm volatile("s_waitcnt vmcnt(0)" ::: "memory")

namespace pg8 {
constexpr int BM = 256, BK = 64, HALF = 128, HTB = HALF * BK * 2, STAGE_BYTES = 8 * HTB, NXCD = 8, WGM = 8;
__host__ __device__ __forceinline__ int lds_byte(int r, int c) { const int st = (r >> 4) * 2 + (c >> 5), rr = r & 15, cc = c & 31, ob = rr * 64 + cc * 2; return st * 1024 + (ob ^ (((ob >> 9) & 1) << 5)); }
__host__ __device__ __forceinline__ void stage_rc(int b, int& R, int& C) { const int st = b / 1024, sb = b % 1024, swz = sb ^ (((sb >> 9) & 1) << 5); R = (st >> 1) * 16 + swz / 64; C = (st & 1) * 32 + (swz % 64) / 2; }
__host__ __device__ __forceinline__ int perm32(int rho) { const int n = rho >> 4, i = rho & 15; return 8 * (i >> 2) + 4 * n + (i & 3); }

struct Unit { int pm, pn, sub; };
struct Gemm { const bf16_t* A; const bf16_t* Bt; int lda, ldb, K; size_t subA, subB; };

template <class Epi, class Sched, bool ALIGN_EPI>
__device__ __forceinline__ void gemm_phase(LAS unsigned char* lds, const int wave_id, const Gemm g, const Sched& S, const Epi& E) {
    const int lane = fresh_lane(), wid = wave_id, tid = wid * 64 + lane, wr = wid >> 2, wc = wid & 3, fr = lane & 15, fq = lane >> 4;
    const int K = g.K, nt = K / BK;
    unsigned voffA[2], voffB[2];
#pragma unroll
    for (int i = 0; i < 2; ++i) { int R, C; stage_rc(tid * 16 + i * 8192, R, C); const int Rb = Epi::PERM ? ((R & ~31) + perm32(R & 31)) : R;
        voffA[i] = (unsigned)(R * g.lda + C) * 2u; voffB[i] = (unsigned)(Rb * g.ldb + C) * 2u; }
    const size_t kstep = (size_t)(BK * 2);
    const size_t hstepA = (size_t)HALF * g.lda * 2, hstepB = (size_t)HALF * g.ldb * 2;
    const size_t tstepA = 2 * hstepA, tstepB = 2 * hstepB;
    const unsigned ldsw = (unsigned)wid * 1024u;
    const int aoff = lds_byte(wr * 64 + fr, fq * 8), boff = lds_byte(wc * 32 + fr, fq * 8);
#define PG8_SA(b, h) (((b) * 2 + (h)) * HTB)
#define PG8_SB(b, h) ((4 + (b) * 2 + (h)) * HTB)
#define PG8_STAGE(bufoff, gbase, voff) do { _Pragma("unroll") for (int _i = 0; _i < 2; ++_i) \
        __builtin_amdgcn_global_load_lds((const unsigned*)((const char*)(gbase) + (voff)[_i]), (LAS unsigned*)(lds + (bufoff) + ldsw + _i * 8192), 16, 0, 0); } while (0)
#define PG8_LDA(dst, b, h) do { _Pragma("unroll") for (int m = 0; m < 4; ++m) _Pragma("unroll") for (int k = 0; k < 2; ++k) dst[m][k] = *(const LAS bf16x8*)(lds + PG8_SA(b, h) + aoff + m * 2048 + k * 1024); } while (0)
#define PG8_LDB(dst, b, h) do { _Pragma("unroll") for (int n = 0; n < 2; ++n) _Pragma("unroll") for (int k = 0; k < 2; ++k) dst[n][k] = *(const LAS bf16x8*)(lds + PG8_SB(b, h) + boff + n * 2048 + k * 1024); } while (0)
#define PG8_MMA(ai, bj, At, Bt) do { __builtin_amdgcn_s_setprio(1); _Pragma("unroll") for (int m = 0; m < 4; ++m) _Pragma("unroll") for (int n = 0; n < 2; ++n) _Pragma("unroll") for (int k = 0; k < 2; ++k) \
        acc[ai][bj][m][n] = __builtin_amdgcn_mfma_f32_16x16x32_bf16(Bt[n][k], At[m][k], acc[ai][bj][m][n], 0, 0, 0); __builtin_amdgcn_s_setprio(0); } while (0)
#define PG8_WAIT_V(n) asm volatile("s_waitcnt vmcnt(" #n ")" ::: "memory")
#define PG8_WAIT_L(n) asm volatile("s_waitcnt lgkmcnt(" #n ")" ::: "memory")
#define PG8_BAR __builtin_amdgcn_s_barrier()
#define PG8_SCHED __builtin_amdgcn_sched_barrier(0)
    Unit cur, nxt; int ui = 0;
    if (!S.next(0, cur)) return;
    f32x4 acc[2][2][4][2];
#pragma unroll
    for (int a = 0; a < 2; ++a)
#pragma unroll
        for (int b = 0; b < 2; ++b)
#pragma unroll
            for (int m = 0; m < 4; ++m)
#pragma unroll
                for (int n = 0; n < 2; ++n) acc[a][b][m][n] = (f32x4){0.f, 0.f, 0.f, 0.f};
    bf16x8 At[4][2], B0[2][2], B1[2][2];
    const char* cA = (const char*)(g.A + (size_t)cur.sub * g.subA) + (size_t)cur.pm * tstepA;
    const char* cB = (const char*)(g.Bt + (size_t)cur.sub * g.subB) + (size_t)cur.pn * tstepB;
    PG8_STAGE(PG8_SB(0, 0), cB, voffB); PG8_STAGE(PG8_SB(0, 1), cB + hstepB, voffB); PG8_STAGE(PG8_SA(0, 0), cA, voffA); PG8_STAGE(PG8_SA(0, 1), cA + hstepA, voffA);
    if (wr == 1) PG8_BAR;
    PG8_WAIT_V(2); PG8_BAR;
    PG8_STAGE(PG8_SB(1, 0), cB + kstep, voffB); PG8_STAGE(PG8_SA(1, 0), cA + kstep, voffA); PG8_STAGE(PG8_SB(1, 1), cB + hstepB + kstep, voffB);
    PG8_WAIT_V(6); PG8_BAR;
    for (;;) {
        const bool has_next = S.next(ui + 1, nxt);
        const char* nA = has_next ? (const char*)(g.A + (size_t)nxt.sub * g.subA) + (size_t)nxt.pm * tstepA : cA;
        const char* nB = has_next ? (const char*)(g.Bt + (size_t)nxt.sub * g.subB) + (size_t)nxt.pn * tstepB : cB;
        for (int t = 0; t < nt; t += 2) {
            const bool last = (t == nt - 2);
            const char* a1 = cA + (size_t)(t + 1) * kstep;
            const char* a2 = last ? nA : cA + (size_t)(t + 2) * kstep; const char* b2 = last ? nB : cB + (size_t)(t + 2) * kstep;
            const char* a3 = a2 + kstep; const char* b3 = b2 + kstep;
            PG8_LDB(B0, 0, 0); PG8_LDB(B1, 0, 1); PG8_SCHED; PG8_LDA(At, 0, 0); PG8_STAGE(PG8_SA(1, 1), a1 + hstepA, voffA);
            PG8_WAIT_V(8); PG8_WAIT_L(0); PG8_BAR; PG8_MMA(0, 0, At, B0); PG8_MMA(0, 1, At, B1); PG8_BAR; PG8_SCHED;
            PG8_LDA(At, 0, 1); PG8_STAGE(PG8_SB(0, 0), b2, voffB); PG8_STAGE(PG8_SB(0, 1), b2 + hstepB, voffB); PG8_STAGE(PG8_SA(0, 0), a2, voffA);
            PG8_WAIT_V(8); PG8_WAIT_L(0); PG8_BAR; PG8_MMA(1, 0, At, B0); PG8_MMA(1, 1, At, B1); PG8_BAR; PG8_SCHED;
            PG8_LDB(B0, 1, 0); PG8_LDB(B1, 1, 1); PG8_SCHED; PG8_LDA(At, 1, 0); PG8_STAGE(PG8_SA(0, 1), a2 + hstepA, voffA);
            PG8_WAIT_V(8); PG8_WAIT_L(0); PG8_BAR; PG8_MMA(0, 0, At, B0); PG8_MMA(0, 1, At, B1); PG8_BAR; PG8_SCHED;
            PG8_LDA(At, 1, 1); PG8_STAGE(PG8_SB(1, 0), b3, voffB); PG8_STAGE(PG8_SB(1, 1), b3 + hstepB, voffB); PG8_STAGE(PG8_SA(1, 0), a3, voffA);
            PG8_WAIT_V(8); PG8_WAIT_L(0); PG8_BAR; PG8_MMA(1, 0, At, B0); PG8_MMA(1, 1, At, B1); PG8_BAR; PG8_SCHED;
        }
        if constexpr (ALIGN_EPI) { if (wr == 0) PG8_BAR; }
        E(acc, cur, wr, wc, fr, fq);
        if (!has_next) break;
#pragma unroll
        for (int a = 0; a < 2; ++a)
#pragma unroll
            for (int b = 0; b < 2; ++b)
#pragma unroll
                for (int m = 0; m < 4; ++m)
#pragma unroll
                    for (int n = 0; n < 2; ++n) acc[a][b][m][n] = (f32x4){0.f, 0.f, 0.f, 0.f};
        cur = nxt; cA = nA; cB = nB; ++ui;
        if constexpr (ALIGN_EPI) { if (wr == 1) PG8_BAR; }
    }
    PG8_WAIT_V(0);
    if constexpr (!ALIGN_EPI) { if (wr == 0) PG8_BAR; }
    PG8_BAR;
#undef PG8_SA
#undef PG8_SB
#undef PG8_STAGE
#undef PG8_LDA
#undef PG8_LDB
#undef PG8_MMA
#undef PG8_WAIT_V
#undef PG8_WAIT_L
#undef PG8_BAR
#undef PG8_SCHED
}
}
using pg8::Unit;

struct SchedG1 {
    int nM, nN, nwg, G, c;
    __device__ __forceinline__ bool next(int i, Unit& u) const {
        const long L = (long)i * G + c; if (L >= nwg) return false;
        int wgid = (int)L; { const int q = nwg / 8, r = nwg % 8, xcd = wgid % 8, off = wgid / 8; wgid = (xcd < r ? xcd * (q + 1) : r * (q + 1) + (xcd - r) * q) + off; }
        const int nig = 8 * nN, gid = wgid / nig, fm = gid * 8, gsz = (nM - fm) < 8 ? (nM - fm) : 8;
        u.pm = fm + ((wgid % nig) % gsz); u.pn = (wgid % nig) / gsz; u.sub = 0; return true;
    }
};
struct SchedSub {
    int vcu, G, nsub;
    __device__ __forceinline__ bool next(int i, Unit& u) const {
        const int j = i / nsub, q = vcu + j * G; if (q >= 256) return false;
        u.pm = q >> 2; u.pn = q & 3; u.sub = i - j * nsub; return true;
    }
};

__device__ __forceinline__ int perm_row(int row, int lg) {
    if (lg == 0 || row >= MP) return row;
    const int t = row & (SEQ - 1), d1 = (1 << lg) - 1;
    return (row & ~(SEQ - 1)) + (t & d1) * (SEQ >> lg) + (t >> lg);
}
struct EpiG1 {
    static constexpr bool PERM = true;
    bf16_t* P; bf16_t* Gt; const float* ssq; const float* cosT; const float* sinT;
    __device__ __forceinline__ void operator()(const f32x4 (&acc)[2][2][4][2], const Unit& u, int wr, int wc, int fr, int fq) const {
        float rs[2][4];
#pragma unroll
        for (int ai = 0; ai < 2; ++ai)
#pragma unroll
            for (int m = 0; m < 4; ++m) { const int row = u.pm * 256 + ai * 128 + wr * 64 + m * 16 + fr;
                const f32x4 p = *(const f32x4*)(ssq + (size_t)row * 16 + 4 * fq); float s = (p.x + p.y) + (p.z + p.w);
                s += __shfl_xor(s, 16); s += __shfl_xor(s, 32); rs[ai][m] = rsqrtf(s * (1.0f / DM) + EPS); }
#pragma unroll
        for (int bj = 0; bj < 2; ++bj) {
            const int hb = 2 * u.pn + bj; if (hb >= NHB) continue;
            const int ch = 32 * wc + 8 * fq;
            if (hb >= 41) {
#pragma unroll
                for (int ai = 0; ai < 2; ++ai)
#pragma unroll
                    for (int m = 0; m < 4; ++m) { const int row = u.pm * 256 + ai * 128 + wr * 64 + m * 16 + fr; const float r = rs[ai][m];
                        const f32x4 v0 = acc[ai][bj][m][0] * r, v1 = acc[ai][bj][m][1] * r; u32x4 w;
                        w.x = pk2(sigmoidf_(v0.x), sigmoidf_(v0.y)); w.y = pk2(sigmoidf_(v0.z), sigmoidf_(v0.w)); w.z = pk2(sigmoidf_(v1.x), sigmoidf_(v1.y)); w.w = pk2(sigmoidf_(v1.z), sigmoidf_(v1.w));
                        *(u32x4*)(Gt + (size_t)row * MRG + (hb - 41) * 128 + ch) = w; }
            } else {
                const bool rope = (hb >= 12 && hb < 16) || (hb >= 29 && hb < 35);
                const int lg = (hb >= 29) ? 2 * ((hb - 29) % 3) : 0;
                if (rope) {
                    const int d0 = 16 * (wc & 1) + 4 * fq, hbase = hb * 128 + 64 * (wc >> 1);
#pragma unroll
                    for (int ai = 0; ai < 2; ++ai)
#pragma unroll
                        for (int m = 0; m < 4; ++m) { const int row = u.pm * 256 + ai * 128 + wr * 64 + m * 16 + fr; const float r = rs[ai][m];
                            const int pi = row < MP ? (row & (SEQ - 1)) : SEQ;
                            const f32x4 c = *(const f32x4*)(cosT + pi * 32 + d0), s = *(const f32x4*)(sinT + pi * 32 + d0);
                            const f32x4 x1 = acc[ai][bj][m][0] * r, x2 = acc[ai][bj][m][1] * r;
                            const f32x4 o1 = x1 * c - x2 * s, o2 = x2 * c + x1 * s;
                            bf16_t* dst = P + (size_t)perm_row(row, lg) * INC + hbase + d0;
                            u32x2 w1, w2; w1.x = pk2(o1.x, o1.y); w1.y = pk2(o1.z, o1.w); w2.x = pk2(o2.x, o2.y); w2.y = pk2(o2.z, o2.w);
                            *(u32x2*)dst = w1; *(u32x2*)(dst + 32) = w2; }
                } else {
#pragma unroll
                    for (int ai = 0; ai < 2; ++ai)
#pragma unroll
                        for (int m = 0; m < 4; ++m) { const int row = u.pm * 256 + ai * 128 + wr * 64 + m * 16 + fr; const float r = rs[ai][m];
                            const f32x4 v0 = acc[ai][bj][m][0] * r, v1 = acc[ai][bj][m][1] * r; u32x4 w;
                            w.x = pk2(v0.x, v0.y); w.y = pk2(v0.z, v0.w); w.z = pk2(v1.x, v1.y); w.w = pk2(v1.z, v1.w);
                            *(u32x4*)(P + (size_t)perm_row(row, lg) * INC + hb * 128 + ch) = w; }
                }
            }
        }
    }
};
struct EpiG2 {
    static constexpr bool PERM = true;
    const bf16_t* Gt; float* scr; bf16_t* mrg;
    __device__ __forceinline__ void operator()(const f32x4 (&acc)[2][2][4][2], const Unit& u, int wr, int wc, int fr_, int fq_) const {
#pragma unroll
        for (int ai = 0; ai < 2; ++ai)
#pragma unroll
            for (int m = 0; m < 4; ++m) {
                const int lane = fresh_lane(), fr = lane & 15, fq = lane >> 4;
                const unsigned row = u.pm * 256 + ai * 128 + wr * 64 + m * 16 + fr;
                const unsigned col = u.pn * 256 + wc * 32 + fq * 8;
                const char* gp = (const char*)Gt + (row * (unsigned)MRG + (unsigned)u.sub * DM + col) * 2u;
                char* sp = (char*)scr + ((unsigned)blockIdx.x * 65536u + ((unsigned)((wr * 4 + wc) * 64 + lane)) * 8u + (unsigned)((ai * 4 + m) * 2) * 4096u) * 4u;
                char* mp = (char*)mrg + (row * (unsigned)DM + col) * 2u;
#pragma unroll
                for (int bj = 0; bj < 2; ++bj) {
                    const u32x4 gw = *(const u32x4*)(gp + bj * 256);
                    f32x4 v0 = acc[ai][bj][m][0], v1 = acc[ai][bj][m][1];
                    v0.x *= bflo(gw.x); v0.y *= bfhi(gw.x); v0.z *= bflo(gw.y); v0.w *= bfhi(gw.y);
                    v1.x *= bflo(gw.z); v1.y *= bfhi(gw.z); v1.z *= bflo(gw.w); v1.w *= bfhi(gw.w);
                    float* s4 = (float*)(sp + bj * 16384);
                    if (u.sub > 0) { v0 += *(const f32x4*)s4; v1 += *(const f32x4*)(s4 + 4); }
                    if (u.sub < 3) { *(f32x4*)s4 = v0; *(f32x4*)(s4 + 4) = v1; }
                    else { u32x4 w; w.x = pk2(v0.x, v0.y); w.y = pk2(v0.z, v0.w); w.z = pk2(v1.x, v1.y); w.w = pk2(v1.z, v1.w);
                        *(u32x4*)(mp + bj * 256) = w; } }
                asm volatile("" ::: "memory"); }
    }
};
struct EpiG3 {
    static constexpr bool PERM = false;
    const float* xold; float* xnew; bf16_t* xb; float* ssq;
    __device__ __forceinline__ void operator()(const f32x4 (&acc)[2][2][4][2], const Unit& u, int wr, int wc, int fr, int fq) const {
#pragma unroll
        for (int ai = 0; ai < 2; ++ai)
#pragma unroll
            for (int m = 0; m < 4; ++m) { const int row = u.pm * 256 + ai * 128 + wr * 64 + m * 16 + fr; float sq = 0.f;
#pragma unroll
                for (int bj = 0; bj < 2; ++bj)
#pragma unroll
                    for (int n = 0; n < 2; ++n) { const size_t off = (size_t)row * DM + u.pn * 256 + bj * 128 + wc * 32 + n * 16 + fq * 4;
                        const f32x4 xn = *(const f32x4*)(xold + off) + acc[ai][bj][m][n];
                        *(f32x4*)(xnew + off) = xn; u32x2 w; w.x = pk2(xn.x, xn.y); w.y = pk2(xn.z, xn.w); *(u32x2*)(xb + off) = w;
                        sq += (xn.x * xn.x + xn.y * xn.y) + (xn.z * xn.z + xn.w * xn.w); }
                sq += __shfl_xor(sq, 16); sq += __shfl_xor(sq, 32);
                if (fq == 0) ssq[(size_t)row * 16 + u.pn * 4 + wc] = sq; }
    }
};

typedef GAS unsigned gu32;
#define RLX_AGENT __ATOMIC_RELAXED, __HIP_MEMORY_SCOPE_AGENT
#define XB_TMO      128
#define XB_XCNT(j)  (256  + 64 * (j))
#define XB_XSUB(j)  (1280 + 64 * (j))
#define XB_XGEN(j)  (2304 + 64 * (j))
#define XB_TOP      3328
#define XB_TOPGEN   3392
#define XCD_BAR_WORDS 3456
#define XB_SPIN_CAP (1u << 18)
__device__ __forceinline__ unsigned xb_ld(unsigned* p)              { return __hip_atomic_load(p, __ATOMIC_RELAXED, __HIP_MEMORY_SCOPE_AGENT); }
__device__ __forceinline__ unsigned xb_add(unsigned* p, unsigned v) { return __hip_atomic_fetch_add(p, v, __ATOMIC_RELAXED, __HIP_MEMORY_SCOPE_AGENT); }
__device__ __forceinline__ unsigned xb_xcc_id() { return (unsigned)__builtin_amdgcn_s_getreg((3 << 11) | 20) & 0xFu; }
#define XB_SPIN(cond, bar) do { unsigned _sp = 0; while (cond) { __builtin_amdgcn_s_sleep(1); \
    if ((++_sp & 255u) == 0u) { if (xb_ld(&(bar)[XB_TMO])) break; if (_sp > XB_SPIN_CAP) { atomicAdd(&(bar)[XB_TMO], 1u); break; } } } } while (0)
struct XcdBarrier { unsigned* bar; unsigned x; volatile LAS unsigned* st; };
__device__ __forceinline__ XcdBarrier xcd_barrier_post(unsigned* bar, volatile LAS unsigned* st) {
    XcdBarrier b; b.bar = bar; b.x = xb_xcc_id(); b.st = st;
    if (threadIdx.x == 0) (void)xb_add(&bar[XB_XCNT(b.x)], 1u);
    return b;
}
__device__ __forceinline__ void xcd_barrier_complete(unsigned* bar, unsigned x, unsigned& nloc, unsigned& nx) {
    const unsigned G = gridDim.x * gridDim.y * gridDim.z;
    unsigned sum, cnt, mine, sp = 0u;
    for (;;) {
        sum = 0u; cnt = 0u; mine = 0u;
#pragma unroll
        for (unsigned j = 0; j < 16; ++j) { const unsigned c = xb_ld(&bar[XB_XCNT(j)]); sum += c; cnt += (c > 0u) ? 1u : 0u; mine = (j == x) ? c : mine; }
        if (sum == G) break;
        __builtin_amdgcn_s_sleep(1);
        if ((++sp & 255u) == 0u) { if (xb_ld(&bar[XB_TMO])) break; if (sp > XB_SPIN_CAP) { atomicAdd(&bar[XB_TMO], 1u); break; } }
    }
    nloc = mine > 0u ? mine : 1u; nx = cnt > 0u ? cnt : 1u;
}
__device__ __forceinline__ void xcd_barrier(const XcdBarrier& b) {
    asm volatile("s_waitcnt vmcnt(0)" ::: "memory");
    __syncthreads();
    if (threadIdx.x == 0) {
        unsigned* bar = b.bar;
        __builtin_amdgcn_s_waitcnt(0);
        unsigned nloc = b.st[0], nx = b.st[1];
        if (nloc == 0u) { xcd_barrier_complete(bar, b.x, nloc, nx); b.st[0] = nloc; b.st[1] = nx; }
        const unsigned old = xb_add(&bar[XB_XSUB(b.x)], 1u);
        const unsigned gen = old / nloc;
        if (old + 1u == (gen + 1u) * nloc) {
            __builtin_amdgcn_fence(__ATOMIC_RELEASE, "agent");
            asm volatile("s_waitcnt vmcnt(0)" ::: "memory");
            const unsigned og = xb_add(&bar[XB_TOP], 1u);
            const unsigned tg = og / nx;
            if (og + 1u == (tg + 1u) * nx) xb_add(&bar[XB_TOPGEN], 1u);
            else XB_SPIN(xb_ld(&bar[XB_TOPGEN]) == tg, bar);
            __builtin_amdgcn_fence(__ATOMIC_ACQUIRE, "agent");
            xb_add(&bar[XB_XGEN(b.x)], 1u);
            asm volatile("s_waitcnt vmcnt(0)" ::: "memory");
        } else {
            XB_SPIN(xb_ld(&bar[XB_XGEN(b.x)]) == gen, bar);
            __builtin_amdgcn_fence(__ATOMIC_ACQUIRE, "agent");
            asm volatile("s_waitcnt vmcnt(0)" ::: "memory");
        }
    }
    __syncthreads();
}

constexpr int NWAVES = 8, NTHR = 512;
constexpr int RING_BYTES = 131072, MISC_OFF = RING_BYTES + 320, LDS_BYTES = 147456;
constexpr int CW_BAR = 4096;

struct Args {
    const float* in[19]; float* out; unsigned char* ws; int ph_lo, ph_hi;
};
#define CAS __attribute__((address_space(4)))
struct Frame {
    LAS unsigned char* lds;
    int wave, vcu, G;
    __device__ __forceinline__ const CAS Args* ap() const { const CAS Args* p = (const CAS Args*)__builtin_amdgcn_kernarg_segment_ptr(); asm volatile("" : "+s"(p)); return p; }
    __device__ __forceinline__ const float* in(int i) const { return ap()->in[i]; }
    __device__ __forceinline__ float* out() const { return ap()->out; }
    __device__ __forceinline__ unsigned char* ws() const { return ap()->ws; }
    __device__ __forceinline__ int lane() const { return fresh_lane(); }
    __device__ __forceinline__ int tid() const { return wave * 64 + fresh_lane(); }
};
enum { I_XP = 0, I_XS, I_SCONV, I_CSWA, I_CD1, I_CD4, I_CD16, I_NG, I_WIN, I_CONVW, I_SINK, I_LNG, I_LNB, I_WSP, I_BSP, I_WBR, I_WMG, I_WOUT, I_FNG };

template <class CMap>
__device__ __forceinline__ void transpose_item(const float* W, int ldw, const float* kscale, bf16_t* WT, int ldwt, int k0, int n0, LAS float* scr, int lane, const CMap& cmap) {
    const int sc = cmap(n0 + (lane & 31));
#pragma unroll 8
    for (int i = 0; i < 32; ++i) { const int kk = 2 * i + (lane >> 5); float v = W[(size_t)(k0 + kk) * ldw + sc]; if (kscale) v *= kscale[k0 + kk]; scr[kk * 33 + (lane & 31)] = v; }
    LDS_WAIT(); asm volatile("" ::: "memory");
    const int c = lane & 7;
#pragma unroll
    for (int j = 0; j < 4; ++j) { const int n = (lane >> 3) + 8 * j; const LAS float* s = scr + (8 * c) * 33 + n;
        u32x4 o; o.x = pk2(s[0 * 33], s[1 * 33]); o.y = pk2(s[2 * 33], s[3 * 33]); o.z = pk2(s[4 * 33], s[5 * 33]); o.w = pk2(s[6 * 33], s[7 * 33]);
        *(u32x4*)(WT + (size_t)(n0 + n) * ldwt + k0 + 8 * c) = o; }
    LDS_WAIT(); asm volatile("" ::: "memory");
}
struct CMapId { int off; __device__ __forceinline__ int operator()(int n) const { return n - off; } };
struct CMapIn {
    __device__ __forceinline__ int operator()(int p) const {
        const int hb = p >> 7; const bool rope = (hb >= 12 && hb < 16) || (hb >= 29 && hb < 35);
        if (!rope) return p;
        const int w = p & 63, j = w >> 3, n = (w >> 2) & 1, i = w & 3; return (p & ~63) + 4 * j + i + 32 * n;
    }
};
__device__ __forceinline__ void cache_shift_copy(Frame& F, const float* src, float* dst, int nrows, int gt, int GT) {
    const size_t nvec = (size_t)DEPTH * DB * nrows * 64;
    const f32x4* s4 = (const f32x4*)src; f32x4* d4 = (f32x4*)dst;
    for (size_t v0 = (size_t)gt; v0 < nvec; v0 += (size_t)GT * 4) {
        f32x4 t[4]; bool ok[4];
#pragma unroll
        for (int k = 0; k < 4; ++k) { const size_t v = v0 + (size_t)k * GT; ok[k] = v < nvec && (int)((v >> 6) % nrows) != nrows - 1; if (ok[k]) t[k] = __builtin_nontemporal_load(s4 + v + 64); }
#pragma unroll
        for (int k = 0; k < 4; ++k) { const size_t v = v0 + (size_t)k * GT; if (ok[k]) __builtin_nontemporal_store(t[k], d4 + v); }
    }
}
__device__ __forceinline__ void p0_prologue(Frame& F) {
    const int lane_ = F.lane(), tid_ = F.wave * 64 + lane_; (void)tid_;
    LAS float* scr = (LAS float*)(F.lds + F.wave * 16384);
    const int gw = F.vcu * NWAVES + F.wave, NGW = F.G * NWAVES;
    constexpr int I_W1 = (DM / 64) * (N1PAD / 32), I_WB = (MIXW / 64) * (DM / 32), I_WO = (DM / 64) * (DM / 32);
    constexpr int NITEMS = DEPTH * (I_W1 + 4 * I_WB + I_WO);
    for (int it = gw; it < NITEMS; it += NGW) {
        int r = it; const int l = r / (I_W1 + 4 * I_WB + I_WO); r -= l * (I_W1 + 4 * I_WB + I_WO);
        if (r < I_W1) {
            const int nblk = N1PAD / 32, kb = r / nblk, nb = r % nblk, n0 = nb * 32, k0 = kb * 64;
            bf16_t* WT = (bf16_t*)(F.ws() + WS_W1T + l * W1T_BYTES);
            const float* ng = F.in(I_NG) + l * DM;
            if (n0 < INC) transpose_item(F.in(I_WIN) + (size_t)l * DM * INC, INC, ng, WT, DM, k0, n0, scr, lane_, CMapIn{});
            else if (n0 < N1) transpose_item(F.in(I_WMG) + (size_t)l * DM * MRG, MRG, ng, WT, DM, k0, n0, scr, lane_, CMapId{INC});
            else { const int c = lane_ & 7;
#pragma unroll
                for (int j = 0; j < 4; ++j) { const int n = (lane_ >> 3) + 8 * j; *(u32x4*)(WT + (size_t)(n0 + n) * DM + k0 + 8 * c) = (u32x4){0u, 0u, 0u, 0u}; } }
            continue;
        }
        r -= I_W1;
        if (r < 4 * I_WB) {
            const int n = r / I_WB, rr = r % I_WB, nblk = DM / 32, kb = rr / nblk, nb = rr % nblk;
            transpose_item(F.in(I_WBR) + ((size_t)l * 4 + n) * MIXW * DM, DM, nullptr, (bf16_t*)(F.ws() + WS_WBT + l * WBT_BYTES) + (size_t)n * DM * MIXW, MIXW, kb * 64, nb * 32, scr, lane_, CMapId{0});
            continue;
        }
        r -= 4 * I_WB;
        { const int nblk = DM / 32, kb = r / nblk, nb = r % nblk;
          transpose_item(F.in(I_WOUT) + (size_t)l * DM * DM, DM, nullptr, (bf16_t*)(F.ws() + WS_WOT + l * WOT_BYTES), DM, kb * 64, nb * 32, scr, lane_, CMapId{0}); }
    }
    const int gt = F.vcu * NTHR + tid_, GT = F.G * NTHR;
    for (int e = gt; e < DEPTH * 6 * 128 * 128; e += GT) { const int s = e & 127, t = (e >> 7) & 127; const float v = F.in(I_WSP)[e];
        ((bf16_t*)(F.ws() + WS_WSP))[e] = (bf16_t)(pk2(s <= t ? v : 0.f, 0.f) & 0xffffu); }
    for (int e = gt; e < 4097 * 32; e += GT) { const int pi = e >> 5, i = e & 31; const double pos = pi < SEQ ? (double)pi : 16384.0;
        const float inv = powf(10000.0f, -(float)i / 32.0f); const float ang = (float)pos * inv;
        ((float*)(F.ws() + WS_COS))[e] = (float)cos((double)ang); ((float*)(F.ws() + WS_SIN))[e] = (float)sin((double)ang); }
    for (int m = gw; m < MPAD; m += NGW) {
        bf16_t* xbr = (bf16_t*)(F.ws() + WS_XB) + (size_t)m * DM; float* sq = (float*)(F.ws() + WS_SSQ) + (size_t)m * 16;
        if (m < MT) {
            const float* xr = m < MP ? F.in(I_XP) + (size_t)m * DM : F.in(I_XS) + (size_t)(m - MP) * DM;
            f32x4 v[4]; float s = 0.f;
#pragma unroll
            for (int j = 0; j < 4; ++j) { v[j] = ((const f32x4*)xr)[lane_ + 64 * j]; s += (v[j].x * v[j].x + v[j].y * v[j].y) + (v[j].z * v[j].z + v[j].w * v[j].w); }
            s = wave_sum(s);
#pragma unroll
            for (int j = 0; j < 4; ++j) { u32x2 w; w.x = pk2(v[j].x, v[j].y); w.y = pk2(v[j].z, v[j].w); ((u32x2*)xbr)[lane_ + 64 * j] = w; }
            if (lane_ < 16) sq[lane_] = lane_ == 0 ? s : 0.f;
        } else {
#pragma unroll
            for (int j = 0; j < 4; ++j) ((u32x2*)xbr)[lane_ + 64 * j] = (u32x2){0u, 0u};
            if (lane_ < 16) sq[lane_] = lane_ == 0 ? (float)DM : 0.f;
        }
    }
    cache_shift_copy(F, F.in(I_CSWA), F.out() + O_SWAS, 128, gt, GT);
    cache_shift_copy(F, F.in(I_CD1), F.out() + O_D1S, 128, gt, GT);
    cache_shift_copy(F, F.in(I_CD4), F.out() + O_D4S, 512, gt, GT);
    cache_shift_copy(F, F.in(I_CD16), F.out() + O_D16S, 2048, gt, GT);
}

struct AttDesc {
    int R0, nb;
    int colK, colV, colQ, colG;
    int nq;
    bf16_t* out; int outcol;
    int orow0, ostride;
    const float* sinks;
    float* lse; int lsecol;
};
__device__ __forceinline__ void att_unit(Frame& F, const AttDesc& D) {
    const bf16_t* P = (const bf16_t*)(F.ws() + WS_P);
    LAS unsigned char* lds = F.lds;
    const int lane = F.lane(), wid = F.wave, tid = wid * 64 + lane, slot = wid >> 2, w = wid & 3, ql = lane & 31, hi = lane >> 5;
    __syncthreads();
#pragma unroll
    for (int s = 0; s < 2; ++s)
#pragma unroll
        for (int it = 0; it < 4; ++it) {
            if (D.nb == 0 && it < 2) continue;
            const int idx = tid + 512 * it, rr = idx >> 3, ch = idx & 7;
            const bf16_t* src = P + (size_t)(D.R0 - 128 + rr) * INC + ch * 8;
            const u32x4 kv = *(const u32x4*)(src + D.colK + 64 * s), vv = *(const u32x4*)(src + D.colV + 64 * s);
            *(LAS u32x4*)(lds + s * 65536 + rr * 128 + ((ch ^ (rr & 7)) << 4)) = kv;
            *(LAS u32x4*)(lds + s * 65536 + 32768 + rr * 128 + ((ch ^ (((rr >> 1) & 1) << 2)) << 4)) = vv;
        }
    __syncthreads();
    const LAS unsigned char* Kb = lds + slot * 65536; const LAS unsigned char* Vb = Kb + 32768;
    const int i16 = lane & 15, q4 = i16 >> 2, p4 = i16 & 3, blk = (lane >> 4) & 1;
    const int c0 = (D.nb == 0) ? (4 - w) : 0;
    const int qrow = D.R0 + 32 * w + ql;
    const int orow = D.orow0 + (32 * w + ql) * D.ostride;
    for (int qi = 0; qi < D.nq; ++qi) {
        const int hq = D.nq * slot + qi;
        bf16x8 qf[4];
#pragma unroll
        for (int d0 = 0; d0 < 4; ++d0) qf[d0] = *(const bf16x8*)(P + (size_t)qrow * INC + D.colQ + 64 * hq + 16 * d0 + 8 * hi);
        f32x16 S[5];
#pragma unroll
        for (int c = 0; c < 5; ++c) {
#pragma unroll
            for (int r = 0; r < 16; ++r) S[c][r] = 0.f;
            if (c >= c0) {
                const int row = 32 * (w + c) + ql;
#pragma unroll
                for (int d0 = 0; d0 < 4; ++d0) { const bf16x8 kf = *(const LAS bf16x8*)(Kb + row * 128 + (((2 * d0 + hi) ^ (row & 7)) << 4));
                    S[c] = __builtin_amdgcn_mfma_f32_32x32x16_bf16(kf, qf[d0], S[c], 0, 0, 0); }
            }
        }
        const float sc = 0.125f * LOG2E; float mx = -1e30f;
#pragma unroll
        for (int c = 0; c < 5; ++c)
#pragma unroll
            for (int r = 0; r < 16; ++r) { const int kr = crow(r, hi);
                const bool valid = (c >= c0) && (c != 0 || kr >= ql) && (c != 4 || kr <= ql);
                const float s = valid ? S[c][r] * sc : -1e30f; S[c][r] = s; mx = fmaxf(mx, s); }
        mx = fmaxf(mx, __shfl_xor(mx, 32));
        float sk2 = 0.f; if (D.sinks) { sk2 = D.sinks[hq] * LOG2E; mx = fmaxf(mx, sk2); }
        float den = 0.f;
#pragma unroll
        for (int c = 0; c < 5; ++c)
#pragma unroll
            for (int r = 0; r < 16; ++r) { const float p = __builtin_amdgcn_exp2f(S[c][r] - mx); S[c][r] = p; den += p; }
        den += __shfl_xor(den, 32);
        if (D.sinks) den += __builtin_amdgcn_exp2f(sk2 - mx);
        const float inv = 1.0f / den;
        if (D.lse && hi == 0) D.lse[(size_t)orow * 8 + D.lsecol + slot] = (mx + __builtin_amdgcn_logf(den)) * LN2;
        f32x16 OT[2];
#pragma unroll
        for (int r = 0; r < 16; ++r) { OT[0][r] = 0.f; OT[1][r] = 0.f; }
#pragma unroll
        for (int c = 0; c < 5; ++c) {
            if (c >= c0) {
#pragma unroll
                for (int ks = 0; ks < 2; ++ks) {
                    u32x4 pw; pw.x = pk2(S[c][8 * ks + 0], S[c][8 * ks + 1]); pw.y = pk2(S[c][8 * ks + 2], S[c][8 * ks + 3]); pw.z = pk2(S[c][8 * ks + 4], S[c][8 * ks + 5]); pw.w = pk2(S[c][8 * ks + 6], S[c][8 * ks + 7]);
                    const bf16x8 pf = __builtin_bit_cast(bf16x8, pw);
                    const int r0 = 32 * (w + c) + 16 * ks + 4 * hi + q4, r1 = r0 + 8;
#pragma unroll
                    for (int db = 0; db < 2; ++db) { const int chk = 4 * db + 2 * blk + (p4 >> 1), wi = 8 * (p4 & 1);
                        const s16x4 lo = __builtin_bit_cast(s16x4, __builtin_amdgcn_ds_read_tr16_b64_v4i16((LAS s16x4*)(Vb + r0 * 128 + ((chk ^ (((r0 >> 1) & 1) << 2)) << 4) + wi)));
                        const s16x4 hh = __builtin_bit_cast(s16x4, __builtin_amdgcn_ds_read_tr16_b64_v4i16((LAS s16x4*)(Vb + r1 * 128 + ((chk ^ (((r1 >> 1) & 1) << 2)) << 4) + wi)));
                        const bf16x8 vf = __builtin_shufflevector(lo, hh, 0, 1, 2, 3, 4, 5, 6, 7);
                        OT[db] = __builtin_amdgcn_mfma_f32_32x32x16_bf16(vf, pf, OT[db], 0, 0, 0); }
                }
            }
        }
        const bf16_t* gp = P + (size_t)qrow * INC + D.colG + 64 * hq; bf16_t* op = D.out + (size_t)orow * MIXW + D.outcol + 64 * hq;
#pragma unroll
        for (int db = 0; db < 2; ++db)
#pragma unroll
            for (int rg = 0; rg < 4; ++rg) { const int d = 32 * db + 8 * rg + 4 * hi; const u32x2 gw = *(const u32x2*)(gp + d);
                const float o0 = OT[db][4 * rg + 0] * inv * siluf_(bflo(gw.x)), o1 = OT[db][4 * rg + 1] * inv * siluf_(bfhi(gw.x)),
                            o2 = OT[db][4 * rg + 2] * inv * siluf_(bflo(gw.y)), o3 = OT[db][4 * rg + 3] * inv * siluf_(bfhi(gw.y));
                u32x2 ow; ow.x = pk2(o0, o1); ow.y = pk2(o2, o3); *(u32x2*)(op + d) = ow; }
    }
}

__device__ __forceinline__ void spatial_unit(Frame& F, int l, int R0) {
    const bf16_t* P = (const bf16_t*)(F.ws() + WS_P);
    bf16_t* BrC = (bf16_t*)(F.ws() + WS_BR + 2 * BR1_BYTES);
    const bf16_t* Wsp = (const bf16_t*)(F.ws() + WS_WSP + l * WSP_BYTES);
    LAS unsigned char* lds = F.lds;
    const int lane = F.lane(), wid = F.wave, ql = lane & 31, hi = lane >> 5;
    __syncthreads();
    { const float* lg = F.in(I_LNG) + l * MIXW; const float* lb = F.in(I_LNB) + l * MIXW;
      float g0[3], g1[3], b0[3], b1[3];
#pragma unroll
      for (int i = 0; i < 3; ++i) { const int c = 2 * lane + 128 * i; g0[i] = lg[c]; g1[i] = lg[c + 1]; b0[i] = lb[c]; b1[i] = lb[c + 1]; }
      for (int tt = 0; tt < 16; ++tt) { const int t = 16 * wid + tt; const bf16_t* src = P + (size_t)(R0 + t) * INC + C_V;
        float x0[3], x1[3]; float s = 0.f;
#pragma unroll
        for (int i = 0; i < 3; ++i) { const unsigned wv = *(const unsigned*)(src + 2 * lane + 128 * i); x0[i] = bflo(wv); x1[i] = bfhi(wv); s += x0[i] + x1[i]; }
        const float mu = wave_sum(s) * (1.0f / MIXW); float q = 0.f;
#pragma unroll
        for (int i = 0; i < 3; ++i) { x0[i] -= mu; x1[i] -= mu; q += x0[i] * x0[i] + x1[i] * x1[i]; }
        const float rstd = rsqrtf(wave_sum(q) * (1.0f / MIXW) + EPS);
#pragma unroll
        for (int i = 0; i < 3; ++i) { const int c = 2 * lane + 128 * i;
            const unsigned o = pk2(x0[i] * rstd * g0[i] + b0[i], x1[i] * rstd * g1[i] + b1[i]);
            *(LAS unsigned*)(lds + t * 768 + (c >> 6) * 128 + ((((c & 63) >> 3) ^ (((t >> 1) & 1) << 2)) << 4) + (c & 7) * 2) = o; } }
    }
    __syncthreads();
    const int i16 = lane & 15, q4 = i16 >> 2, p4 = i16 & 3, blk = (lane >> 4) & 1;
    const float* bsp = F.in(I_BSP) + l * 6 * 128;
    for (int tile = wid; tile < 48; tile += 8) {
        const int tb = tile & 3, gd = tile >> 2, g = gd >> 1, db = gd & 1;
        f32x16 acc;
#pragma unroll
        for (int r = 0; r < 16; ++r) acc[r] = 0.f;
        const int t = 32 * tb + ql;
        const bf16_t* wrow = Wsp + ((size_t)g * 128 + t) * 128;
        const int chk = 4 * db + 2 * blk + (p4 >> 1), wi = 8 * (p4 & 1);
        for (int ks = 0; ks < 2 * (tb + 1); ++ks) {
            const bf16x8 wf = *(const bf16x8*)(wrow + 16 * ks + 8 * hi);
            const int r0 = 16 * ks + 8 * hi + q4, r1 = r0 + 4;
            const s16x4 lo = __builtin_bit_cast(s16x4, __builtin_amdgcn_ds_read_tr16_b64_v4i16((LAS s16x4*)(lds + r0 * 768 + g * 128 + ((chk ^ (((r0 >> 1) & 1) << 2)) << 4) + wi)));
            const s16x4 hh = __builtin_bit_cast(s16x4, __builtin_amdgcn_ds_read_tr16_b64_v4i16((LAS s16x4*)(lds + r1 * 768 + g * 128 + ((chk ^ (((r1 >> 1) & 1) << 2)) << 4) + wi)));
            const bf16x8 vf = __builtin_shufflevector(lo, hh, 0, 1, 2, 3, 4, 5, 6, 7);
            acc = __builtin_amdgcn_mfma_f32_32x32x16_bf16(vf, wf, acc, 0, 0, 0);
        }
        const float bias = bsp[g * 128 + t];
        const bf16_t* up = P + (size_t)(R0 + t) * INC + C_U + 64 * g; const bf16_t* gp = P + (size_t)(R0 + t) * INC + C_G + 64 * g;
        bf16_t* op = BrC + (size_t)(R0 + t) * MIXW + 64 * g;
#pragma unroll
        for (int rg = 0; rg < 4; ++rg) { const int d = 32 * db + 8 * rg + 4 * hi; const u32x2 uw = *(const u32x2*)(up + d), gw = *(const u32x2*)(gp + d);
            const float o0 = bflo(uw.x) * (acc[4 * rg + 0] + bias) * siluf_(bflo(gw.x)), o1 = bfhi(uw.x) * (acc[4 * rg + 1] + bias) * siluf_(bfhi(gw.x)),
                        o2 = bflo(uw.y) * (acc[4 * rg + 2] + bias) * siluf_(bflo(gw.y)), o3 = bfhi(uw.y) * (acc[4 * rg + 3] + bias) * siluf_(bfhi(gw.y));
            u32x2 ow; ow.x = pk2(o0, o1); ow.y = pk2(o2, o3); *(u32x2*)(op + d) = ow; }
    }
}

__device__ __forceinline__ void conv_unit(Frame& F, int l, int b, int t0) {
    const int lane_ = F.lane(), tid_ = F.wave * 64 + lane_; (void)tid_;
    const bf16_t* P = (const bf16_t*)(F.ws() + WS_P);
    bf16_t* BrA = (bf16_t*)(F.ws() + WS_BR);
    const float* cw = F.in(I_CONVW) + l * 3 * MIXW;
    for (int it = 0; it < 12; ++it) {
        const int idx = tid_ + 512 * it, tl = idx / 48, c8 = (idx % 48) * 8, t = t0 + tl; const size_t row = (size_t)b * SEQ + t;
        const bf16_t* pr = P + row * INC;
        const u32x4 ab = *(const u32x4*)(pr + A_B + c8), ag = *(const u32x4*)(pr + A_G + c8);
        u32x4 ac[3], ah[3];
#pragma unroll
        for (int k = 0; k < 3; ++k) { if (t - k >= 0) { ac[k] = *(const u32x4*)(pr - (size_t)k * INC + A_C + c8); ah[k] = *(const u32x4*)(pr - (size_t)k * INC + A_H + c8); } else { ac[k] = (u32x4){0u, 0u, 0u, 0u}; ah[k] = ac[k]; } }
        float y[8];
#pragma unroll
        for (int e = 0; e < 8; ++e) { const int wdx = e >> 1; const bool hi = e & 1;
            auto pick = [&](const u32x4& v) { const unsigned wv = wdx == 0 ? v.x : wdx == 1 ? v.y : wdx == 2 ? v.z : v.w; return hi ? bfhi(wv) : bflo(wv); };
            const float z0 = pick(ac[0]) * pick(ah[0]), z1 = pick(ac[1]) * pick(ah[1]), z2 = pick(ac[2]) * pick(ah[2]);
            const float conv = cw[c8 + e] * z2 + cw[MIXW + c8 + e] * z1 + cw[2 * MIXW + c8 + e] * z0;
            y[e] = pick(ab) * conv * siluf_(pick(ag)); }
        u32x4 o; o.x = pk2(y[0], y[1]); o.y = pk2(y[2], y[3]); o.z = pk2(y[4], y[5]); o.w = pk2(y[6], y[7]);
        *(u32x4*)(BrA + row * MIXW + c8) = o;
    }
}

__device__ __forceinline__ void prompt_outputs(Frame& F, int l) {
    const int lane_ = F.lane(), tid_ = F.wave * 64 + lane_; (void)tid_;
    const bf16_t* P = (const bf16_t*)(F.ws() + WS_P);
    const int gt = F.vcu * NTHR + tid_, GT = F.G * NTHR;
    constexpr int U_SWA = NBAT * 128 * 4 * 8, U_D1 = U_SWA, U_D4 = NBAT * 512 * 4 * 8, U_D16 = NBAT * 2048 * 4 * 8, U_CV = NBAT * 2 * 48;
    constexpr int U_ALL = U_SWA + U_D1 + U_D4 + U_D16 + U_CV;
    for (int e = gt; e < U_ALL; e += GT) {
        int r = e; const bf16_t* src; float* dst; bool conv = false; const bf16_t* src2 = nullptr;
        if (r < U_SWA) { const int c8 = r & 7, hr = r >> 3, h = hr & 1, kv = (hr >> 1) & 1, i = (hr >> 2) & 127, b = hr >> 9;
            src = P + (size_t)(b * SEQ + SEQ - 128 + i) * INC + (kv ? S_V : S_K) + 64 * h + 8 * c8; dst = F.out() + O_SWAP + (size_t)l * NBAT * 128 * 256 + (size_t)hr * 64 + 8 * c8; }
        else if ((r -= U_SWA) < U_D1 + U_D4 + U_D16) {
            int g, W, lg; size_t ob;
            if (r < U_D1) { g = 0; W = 128; lg = 0; ob = O_D1P; } else if ((r -= U_D1) < U_D4) { g = 1; W = 512; lg = 2; ob = O_D4P; } else { r -= U_D4; g = 2; W = 2048; lg = 4; ob = O_D16P; }
            const int c8 = r & 7, hr = r >> 3, j = hr & 1, kv = (hr >> 1) & 1, i = (hr >> 2) % W, b = (hr >> 2) / W;
            const int row = perm_row(b * SEQ + SEQ - W + i, lg);
            src = P + (size_t)row * INC + (kv ? D_V : D_K) + 64 * (2 * g + j) + 8 * c8; dst = F.out() + ob + (size_t)l * NBAT * W * 256 + (size_t)hr * 64 + 8 * c8; }
        else { r -= U_D1 + U_D4 + U_D16; const int c8 = r % 48, i = (r / 48) & 1, b = r / 96; conv = true;
            src = P + (size_t)(b * SEQ + SEQ - 2 + i) * INC + A_C + 8 * c8; src2 = src + (A_H - A_C); dst = F.out() + O_CONVP + ((size_t)(l * NBAT + b) * 2 + i) * MIXW + 8 * c8; }
        const u32x4 v = *(const u32x4*)src; f32x4 o0 = {bflo(v.x), bfhi(v.x), bflo(v.y), bfhi(v.y)}, o1 = {bflo(v.z), bfhi(v.z), bflo(v.w), bfhi(v.w)};
        if (conv) { const u32x4 v2 = *(const u32x4*)src2; o0 *= (f32x4){bflo(v2.x), bfhi(v2.x), bflo(v2.y), bfhi(v2.y)}; o1 *= (f32x4){bflo(v2.z), bfhi(v2.z), bflo(v2.w), bfhi(v2.w)}; }
        *(f32x4*)dst = o0; *(f32x4*)(dst + 4) = o1;
    }
}

__device__ __forceinline__ void sample_unit(Frame& F, int l, int b) {
    const bf16_t* P = (const bf16_t*)(F.ws() + WS_P);
    LAS float* pc = (LAS float*)F.lds;
    LAS float* pbuf = (LAS float*)(F.lds + 24576);
    LAS float* obuf = (LAS float*)(F.lds + 32768);
    LAS float* lsb = (LAS float*)(F.lds + 32768 + 4096);
    const int lane = F.lane(), wid = F.wave, tid = wid * 64 + lane; const size_t m = (size_t)MP + b;
    __syncthreads();
    for (int v = tid; v < INC / 8; v += NTHR) { const u32x4 w = *(const u32x4*)(P + m * INC + 8 * v); LAS float* d = pc + 8 * v;
        d[0] = bflo(w.x); d[1] = bfhi(w.x); d[2] = bflo(w.y); d[3] = bfhi(w.y); d[4] = bflo(w.z); d[5] = bfhi(w.z); d[6] = bflo(w.w); d[7] = bfhi(w.w); }
    __syncthreads();
    for (int task = wid; task < 12; task += 8) {
        const bool swa = task < 6; const int hd = swa ? task : task - 6;
        int colQ, colK, colV, n, dil, kvh; const float* cache; float* cout;
        if (swa) { kvh = hd / 3; colQ = S_Q + 64 * hd; colK = S_K + 64 * kvh; colV = S_V + 64 * kvh; n = 128; dil = 1;
            cache = F.in(I_CSWA) + ((size_t)l * DB + b) * 128 * 256; cout = F.out() + O_SWAS + ((size_t)l * DB + b) * 128 * 256; }
        else { const int g = hd >> 1; kvh = hd & 1; colQ = D_Q + 64 * hd; colK = D_K + 64 * hd; colV = D_V + 64 * hd;
            n = g == 0 ? 128 : g == 1 ? 512 : 2048; dil = g == 0 ? 1 : g == 1 ? 4 : 16;
            cache = F.in(g == 0 ? I_CD1 : g == 1 ? I_CD4 : I_CD16) + ((size_t)l * DB + b) * n * 256;
            cout = F.out() + (g == 0 ? O_D1S : g == 1 ? O_D4S : O_D16S) + ((size_t)l * DB + b) * n * 256; }
        float s[2];
#pragma unroll
        for (int j = 0; j < 2; ++j) { const int kk = lane + 1 + 64 * j; const float* kr = cache + ((size_t)(n - dil * kk) * 4 + kvh) * 64; float a = 0.f;
#pragma unroll
            for (int d4 = 0; d4 < 16; ++d4) { const f32x4 kx = *(const f32x4*)(kr + 4 * d4); const LAS float* q = pc + colQ + 4 * d4; a += kx.x * q[0] + kx.y * q[1] + kx.z * q[2] + kx.w * q[3]; }
            s[j] = a * 0.125f; }
        float s0; { const float a = pc[colQ + lane] * pc[colK + lane]; s0 = wave_sum(a) * 0.125f; }
        float mx = fmaxf(wave_max(fmaxf(s[0], s[1])), s0); float sk = 0.f;
        if (swa) { sk = F.in(I_SINK)[l * 6 + hd]; mx = fmaxf(mx, sk); }
        const float p0 = __expf(s[0] - mx), p1 = __expf(s[1] - mx), pn = __expf(s0 - mx);
        float den = wave_sum(p0 + p1) + pn; if (swa) den += __expf(sk - mx);
        LAS float* pb = pbuf + wid * 192; pb[lane] = p0; pb[64 + lane] = p1; LDS_WAIT();
        float o = pn * pc[colV + lane];
        const float* vbase = cache + (size_t)(2 + kvh) * 64 + lane;
#pragma unroll 8
        for (int kk = 1; kk <= 128; ++kk) o += pb[kk - 1] * vbase[(size_t)(n - dil * kk) * 256];
        obuf[task * 64 + lane] = o / den;
        if (!swa && lane == 0) lsb[hd] = mx + __logf(den);
        if (swa ? (hd % 3 == 0) : true) { float* cr = cout + (size_t)(n - 1) * 256; cr[kvh * 64 + lane] = pc[colK + lane]; cr[128 + kvh * 64 + lane] = pc[colV + lane]; }
    }
    __syncthreads();
    if (tid < MIXW) {
        const int c = tid; const size_t lb = (size_t)l * DB + b;
        { const float z = pc[A_C + c] * pc[A_H + c]; const float* st = F.in(I_SCONV) + lb * 2 * MIXW; const float pv0 = st[c], pv1 = st[MIXW + c];
          const float* cw = F.in(I_CONVW) + l * 3 * MIXW; const float conv = cw[c] * pv0 + cw[MIXW + c] * pv1 + cw[2 * MIXW + c] * z;
          const float y = pc[A_B + c] * conv * siluf_(pc[A_G + c]);
          ((bf16_t*)(F.ws() + WS_BR))[m * MIXW + c] = (bf16_t)(pk2(y, 0.f) & 0xffffu);
          float* co = F.out() + O_CONVS + lb * 2 * MIXW; co[c] = pv1; co[MIXW + c] = z; }
        { const float y = obuf[(c >> 6) * 64 + (c & 63)] * siluf_(pc[S_G + c]); ((bf16_t*)(F.ws() + WS_BR + BR1_BYTES))[m * MIXW + c] = (bf16_t)(pk2(y, 0.f) & 0xffffu); }
        { const int hd = c >> 6, g = hd >> 1, j = hd & 1; const float l0 = lsb[j], l1 = lsb[2 + j], l2 = lsb[4 + j]; const float lm = fmaxf(l0, fmaxf(l1, l2));
          const float e0 = __expf(l0 - lm), e1 = __expf(l1 - lm), e2 = __expf(l2 - lm); const float al = (g == 0 ? e0 : g == 1 ? e1 : e2) / (e0 + e1 + e2);
          const float y = obuf[(6 + hd) * 64 + (c & 63)] * al * siluf_(pc[D_G + c]); ((bf16_t*)(F.ws() + WS_BR + 3 * BR1_BYTES))[m * MIXW + c] = (bf16_t)(pk2(y, 0.f) & 0xffffu); }
    }
    if (wid == 6) {
        const size_t lb = (size_t)l * DB + b; float x[6]; float s = 0.f;
#pragma unroll
        for (int i = 0; i < 6; ++i) { x[i] = pc[C_V + lane + 64 * i]; s += x[i]; }
        const float mu = wave_sum(s) * (1.0f / MIXW); float q = 0.f;
#pragma unroll
        for (int i = 0; i < 6; ++i) { x[i] -= mu; q += x[i] * x[i]; }
        const float rstd = rsqrtf(wave_sum(q) * (1.0f / MIXW) + EPS);
#pragma unroll
        for (int i = 0; i < 6; ++i) { const int c = lane + 64 * i; const float vn = x[i] * rstd * F.in(I_LNG)[l * MIXW + c] + F.in(I_LNB)[l * MIXW + c];
            F.out()[O_CHV + lb * MIXW + c] = vn;
            const float w00 = F.in(I_WSP)[((size_t)l * 6 + i) * 128 * 128], b0 = F.in(I_BSP)[(l * 6 + i) * 128];
            const float y = pc[C_U + c] * (w00 * vn + b0) * siluf_(pc[C_G + c]);
            ((bf16_t*)(F.ws() + WS_BR + 2 * BR1_BYTES))[m * MIXW + c] = (bf16_t)(pk2(y, 0.f) & 0xffffu); }
    }
}

__device__ __forceinline__ void mix_phase(Frame& F, int l) {
    const int c = F.vcu;
    bf16_t* BrB = (bf16_t*)(F.ws() + WS_BR + BR1_BYTES); bf16_t* BrD = (bf16_t*)(F.ws() + WS_BR + 3 * BR1_BYTES);
    float* lse = (float*)(F.ws() + WS_LSE);
    for (int k = 0; k < 3; ++k) {
        AttDesc D;
        if (k < 2) {
            const int u = (k == 0) ? c : c + 128; if ((k == 1 && c < 128) || u >= 384) continue;
            const int g = u >> 7, rem = u & 127, b = rem >> 5, blkid = rem & 31, lg = 2 * g, d = 1 << lg, L = SEQ >> lg, bpr = L >> 7, r = blkid / bpr, nb = blkid % bpr;
            D.R0 = b * SEQ + r * L + 128 * nb; D.nb = nb; D.colK = D_K + 128 * g; D.colV = D_V + 128 * g; D.colQ = D_Q + 128 * g; D.colG = D_G + 128 * g; D.nq = 1;
            D.out = BrD; D.outcol = 128 * g; D.orow0 = b * SEQ + 128 * nb * d + r; D.ostride = d; D.sinks = nullptr; D.lse = lse; D.lsecol = 2 * g;
        } else {
            if (c >= 128) continue;
            const int b = c >> 5, nb = c & 31;
            D.R0 = b * SEQ + 128 * nb; D.nb = nb; D.colK = S_K; D.colV = S_V; D.colQ = S_Q; D.colG = S_G; D.nq = 3;
            D.out = BrB; D.outcol = 0; D.orow0 = D.R0; D.ostride = 1; D.sinks = F.in(I_SINK) + l * 6; D.lse = nullptr; D.lsecol = 0;
        }
        att_unit(F, D);
    }
    if (c >= 128) {
        const int q = c - 128, b = q >> 5, ch = q & 31;
        spatial_unit(F, l, b * SEQ + 128 * ch);
        conv_unit(F, l, b, 128 * ch);
        sample_unit(F, l, q);
    }
    prompt_outputs(F, l);
}
__device__ __forceinline__ void fin_phase(Frame& F) {
    const int lane_ = F.lane(), tid_ = F.wave * 64 + lane_; (void)tid_;
    bf16_t* BrD = (bf16_t*)(F.ws() + WS_BR + 3 * BR1_BYTES); const float* lse = (const float*)(F.ws() + WS_LSE);
    const int gt = F.vcu * NTHR + tid_, GT = F.G * NTHR;
    for (int e = gt; e < MP * 48; e += GT) { const int row = e / 48, c8 = (e % 48) * 8, hd = c8 >> 6, g = hd >> 1, j = hd & 1;
        const float* lr = lse + (size_t)row * 8; const float l0 = lr[j], l1 = lr[2 + j], l2 = lr[4 + j], lm = fmaxf(l0, fmaxf(l1, l2));
        const float e0 = __expf(l0 - lm), e1 = __expf(l1 - lm), e2 = __expf(l2 - lm), al = (g == 0 ? e0 : g == 1 ? e1 : e2) / (e0 + e1 + e2);
        u32x4* p = (u32x4*)(BrD + (size_t)row * MIXW + c8); const u32x4 v = *p; u32x4 o;
        o.x = pk2(bflo(v.x) * al, bfhi(v.x) * al); o.y = pk2(bflo(v.y) * al, bfhi(v.y) * al); o.z = pk2(bflo(v.z) * al, bfhi(v.z) * al); o.w = pk2(bflo(v.w) * al, bfhi(v.w) * al);
        *p = o; }
}

__device__ __forceinline__ void thin_g2(Frame& F, int l, int unit) {
    const bf16_t* Br = (const bf16_t*)(F.ws() + WS_BR); const bf16_t* WbT = (const bf16_t*)(F.ws() + WS_WBT + l * WBT_BYTES); const bf16_t* Gt = (const bf16_t*)(F.ws() + WS_G);
    bf16_t* mrg = (bf16_t*)(F.ws() + WS_MRG);
    const int lane = F.lane(), fr = lane & 15, fq = lane >> 4; const size_t row = (size_t)MP + 16 * F.wave + fr; const int col0 = 64 * unit;
    f32x4 mg[4];
#pragma unroll
    for (int c = 0; c < 4; ++c) mg[c] = (f32x4){0.f, 0.f, 0.f, 0.f};
    for (int n = 0; n < 4; ++n) {
        f32x4 acc[4];
#pragma unroll
        for (int c = 0; c < 4; ++c) acc[c] = (f32x4){0.f, 0.f, 0.f, 0.f};
        const bf16_t* ap = Br + (size_t)n * MPAD * MIXW + row * MIXW + 8 * fq; const bf16_t* bp = WbT + (size_t)n * DM * MIXW + (size_t)(col0 + fr) * MIXW + 8 * fq;
#pragma unroll 4
        for (int k = 0; k < MIXW; k += 32) { const bf16x8 a = *(const bf16x8*)(ap + k);
#pragma unroll
            for (int c = 0; c < 4; ++c) { const bf16x8 bb = *(const bf16x8*)(bp + (size_t)16 * c * MIXW + k); acc[c] = __builtin_amdgcn_mfma_f32_16x16x32_bf16(bb, a, acc[c], 0, 0, 0); } }
#pragma unroll
        for (int c = 0; c < 4; ++c) { const u32x2 gw = *(const u32x2*)(Gt + row * MRG + n * DM + col0 + 16 * c + 4 * fq);
            mg[c].x += acc[c].x * bflo(gw.x); mg[c].y += acc[c].y * bfhi(gw.x); mg[c].z += acc[c].z * bflo(gw.y); mg[c].w += acc[c].w * bfhi(gw.y); }
    }
#pragma unroll
    for (int c = 0; c < 4; ++c) { u32x2 w; w.x = pk2(mg[c].x, mg[c].y); w.y = pk2(mg[c].z, mg[c].w); *(u32x2*)(mrg + row * DM + col0 + 16 * c + 4 * fq) = w; }
}
__device__ __forceinline__ void thin_g3(Frame& F, int l, int unit, const float* xold, float* xnew) {
    const bf16_t* mrg = (const bf16_t*)(F.ws() + WS_MRG); const bf16_t* WoT = (const bf16_t*)(F.ws() + WS_WOT + l * WOT_BYTES);
    bf16_t* xb = (bf16_t*)(F.ws() + WS_XB); float* ssq = (float*)(F.ws() + WS_SSQ);
    const int lane = F.lane(), fr = lane & 15, fq = lane >> 4; const int lr = 16 * F.wave + fr; const size_t row = (size_t)MP + lr; const int col0 = 64 * unit;
    f32x4 acc[4];
#pragma unroll
    for (int c = 0; c < 4; ++c) acc[c] = (f32x4){0.f, 0.f, 0.f, 0.f};
    const bf16_t* ap = mrg + row * DM + 8 * fq; const bf16_t* bp = WoT + (size_t)(col0 + fr) * DM + 8 * fq;
#pragma unroll 4
    for (int k = 0; k < DM; k += 32) { const bf16x8 a = *(const bf16x8*)(ap + k);
#pragma unroll
        for (int c = 0; c < 4; ++c) { const bf16x8 bb = *(const bf16x8*)(bp + (size_t)16 * c * DM + k); acc[c] = __builtin_amdgcn_mfma_f32_16x16x32_bf16(bb, a, acc[c], 0, 0, 0); } }
    float sq = 0.f;
#pragma unroll
    for (int c = 0; c < 4; ++c) { const size_t off = (size_t)lr * DM + col0 + 16 * c + 4 * fq; const f32x4 xn = *(const f32x4*)(xold + off) + acc[c];
        *(f32x4*)(xnew + off) = xn; u32x2 w; w.x = pk2(xn.x, xn.y); w.y = pk2(xn.z, xn.w); *(u32x2*)(xb + row * DM + col0 + 16 * c + 4 * fq) = w;
        sq += (xn.x * xn.x + xn.y * xn.y) + (xn.z * xn.z + xn.w * xn.w); }
    sq += __shfl_xor(sq, 16); sq += __shfl_xor(sq, 32);
    if (fq == 0) ssq[row * 16 + unit] = sq;
}

__device__ __forceinline__ void final_phase(Frame& F) {
    const int lane_ = F.lane(), tid_ = F.wave * 64 + lane_; (void)tid_;
    const int gw = F.vcu * NWAVES + F.wave, NGW = F.G * NWAVES; const float* ssq = (const float*)(F.ws() + WS_SSQ); const float* fg = F.in(I_FNG);
    f32x4 gv[4];
#pragma unroll
    for (int j = 0; j < 4; ++j) gv[j] = ((const f32x4*)fg)[lane_ + 64 * j];
    for (int m = gw; m < MT; m += NGW) {
        const f32x4* sp = (const f32x4*)(ssq + (size_t)m * 16); const f32x4 a = sp[0], b = sp[1], c = sp[2], d = sp[3];
        const float s = ((a.x + a.y) + (a.z + a.w)) + ((b.x + b.y) + (b.z + b.w)) + ((c.x + c.y) + (c.z + c.w)) + ((d.x + d.y) + (d.z + d.w));
        const float rstd = rsqrtf(s * (1.0f / DM) + EPS);
        f32x4* xr = (f32x4*)(F.out() + (size_t)m * DM);
#pragma unroll
        for (int j = 0; j < 4; ++j) { f32x4 v = xr[lane_ + 64 * j]; v = v * rstd * gv[j]; xr[lane_ + 64 * j] = v; }
    }
}

#ifndef DIAG_MASK
#define DIAG_MASK 0xFFFF
#endif
#define IN(k) ((((DIAG_MASK) >> ((k) > 5 && (k) < 11 ? (k) - 5 : (k))) & 1) && lo <= (k) && (k) < hi)
#define SEAM(k) do { if (IN(k) && IN((k) + 1)) xcd_barrier(bar); } while (0)
template <int l>
__device__ __forceinline__ void layer_phases(Frame& F, const int lo, const int hi, const XcdBarrier& bar) {
        const int pb = 1 + 5 * l;
        if (IN(pb)) {
            pg8::Gemm g{(const bf16_t*)(F.ws() + WS_XB), (const bf16_t*)(F.ws() + WS_W1T + l * W1T_BYTES), DM, DM, DM, 0, 0};
            SchedG1 S; S.nM = MPAD / 256; S.nN = N1PAD / 256; S.nwg = S.nM * S.nN; S.G = F.G; S.c = (int)blockIdx.x;
            EpiG1 E{(bf16_t*)(F.ws() + WS_P), (bf16_t*)(F.ws() + WS_G), (const float*)(F.ws() + WS_SSQ), (const float*)(F.ws() + WS_COS), (const float*)(F.ws() + WS_SIN)};
            pg8::gemm_phase<EpiG1, SchedG1, true>(F.lds, F.wave, g, S, E);
        }
        SEAM(pb);
        if (IN(pb + 1)) { mix_phase(F, l); }
        SEAM(pb + 1);
        if (IN(pb + 2)) { fin_phase(F); }
        SEAM(pb + 2);
        if (IN(pb + 3)) {
            pg8::Gemm g{(const bf16_t*)(F.ws() + WS_BR), (const bf16_t*)(F.ws() + WS_WBT + l * WBT_BYTES), MIXW, MIXW, MIXW, (size_t)MPAD * MIXW, (size_t)DM * MIXW};
            SchedSub S{F.vcu, F.G, 4};
            EpiG2 E{(const bf16_t*)(F.ws() + WS_G), (float*)(F.ws() + WS_SCR), (bf16_t*)(F.ws() + WS_MRG)};
            pg8::gemm_phase<EpiG2, SchedSub, false>(F.lds, F.wave, g, S, E);
            for (int u = F.vcu; u < 16; u += F.G) thin_g2(F, l, u);
        }
        SEAM(pb + 3);
        if (IN(pb + 4)) {
            const float* xold_p = l == 0 ? F.in(I_XP) : (const float*)(F.ws() + WS_X1);
            const float* xold_s = l == 0 ? F.in(I_XS) : (const float*)(F.ws() + WS_X1) + (size_t)MP * DM;
            float* xnew = l == DEPTH - 1 ? F.out() : (float*)(F.ws() + WS_X1);
            pg8::Gemm g{(const bf16_t*)(F.ws() + WS_MRG), (const bf16_t*)(F.ws() + WS_WOT + l * WOT_BYTES), DM, DM, DM, 0, 0};
            SchedSub S{F.vcu, F.G, 1};
            EpiG3 E{xold_p, xnew, (bf16_t*)(F.ws() + WS_XB), (float*)(F.ws() + WS_SSQ)};
            pg8::gemm_phase<EpiG3, SchedSub, false>(F.lds, F.wave, g, S, E);
            for (int u = F.vcu; u < 16; u += F.G) thin_g3(F, l, u, xold_s, xnew + (size_t)MP * DM);
        }
        SEAM(pb + 4);
}
constexpr int N_PHASES = 12;
__global__ void __launch_bounds__(NTHR, 2) mk_fwd(Args args) {
    extern __shared__ __attribute__((aligned(16))) unsigned char lds_raw[];
    Frame F;
    F.lds = (LAS unsigned char*)lds_raw;
    F.wave = __builtin_amdgcn_readfirstlane(threadIdx.x >> 6);
    F.G = gridDim.x; { const int bx = blockIdx.x; F.vcu = (F.G % 8 == 0) ? (bx % 8) * (F.G / 8) + bx / 8 : bx; }
    volatile LAS unsigned* MISC = (volatile LAS unsigned*)(F.lds + MISC_OFF);
    for (int u = threadIdx.x; u < (LDS_BYTES - RING_BYTES) / 4; u += NTHR) ((LAS unsigned*)(F.lds + RING_BYTES))[u] = 0u;
    __syncthreads();
    const int lo = args.ph_lo, hi = args.ph_hi;
    const bool one_launch = (hi - lo) > 1;
    XcdBarrier bar; bar.bar = (unsigned*)(F.ws() + WS_CTL) + CW_BAR; bar.x = 0; bar.st = nullptr;
    if (one_launch) bar = xcd_barrier_post((unsigned*)(F.ws() + WS_CTL) + CW_BAR, MISC + 8);

    if (IN(0)) { p0_prologue(F); }
    SEAM(0);
    layer_phases<0>(F, lo, hi, bar);
    layer_phases<1>(F, lo, hi, bar);
    if (IN(11)) { final_phase(F); }
#undef IN
#undef SEAM
}

#ifndef MK_N_LAUNCHES
#define MK_N_LAUNCHES 1
#endif
extern "C" void kernel_launch(void* const* d_in, const int* in_sizes, int n_in, void* d_out, int out_size, void* d_ws, size_t ws_size, hipStream_t stream) {
    static int grid = 0;
    if (grid == 0) {
        if (n_in != 19 || (size_t)out_size != O_END || ws_size < WS_END) { fprintf(stderr, "kernel_launch: unexpected shapes (n_in %d out %d ws %zu need %zu)\n", n_in, out_size, ws_size, (size_t)WS_END); grid = -1; return; }
        int dev = 0, cus = 0, per_cu = 0;
        if (hipGetDevice(&dev) != hipSuccess || hipDeviceGetAttribute(&cus, hipDeviceAttributeMultiprocessorCount, dev) != hipSuccess) { grid = -1; return; }
        if (hipFuncSetAttribute((const void*)mk_fwd, hipFuncAttributeMaxDynamicSharedMemorySize, LDS_BYTES) != hipSuccess) { fprintf(stderr, "kernel_launch: hipFuncSetAttribute failed\n"); grid = -1; return; }
        if (hipOccupancyMaxActiveBlocksPerMultiprocessor(&per_cu, (const void*)mk_fwd, NTHR, LDS_BYTES) != hipSuccess || per_cu < 1) { fprintf(stderr, "kernel_launch: occupancy query says %d\n", per_cu); }
        (void)hipGetLastError();
        grid = cus;
        if (grid != 256) fprintf(stderr, "kernel_launch: %d CUs (built for 256)\n", grid);
    }
    if (grid < 0) return;
    (void)hipMemsetAsync((char*)d_ws + WS_CTL, 0, CTL_BYTES, stream);
    Args a{};
    for (int i = 0; i < 19; ++i) a.in[i] = (const float*)d_in[i];
    a.out = (float*)d_out; a.ws = (unsigned char*)d_ws;
#if MK_N_LAUNCHES == 1
    a.ph_lo = 0; a.ph_hi = N_PHASES;
    hipLaunchKernelGGL(mk_fwd, dim3(grid), dim3(NTHR), LDS_BYTES, stream, a);
#else
    for (int p = 0; p < N_PHASES; ++p) { a.ph_lo = p; a.ph_hi = p + 1; hipLaunchKernelGGL(mk_fwd, dim3(grid), dim3(NTHR), LDS_BYTES, stream, a); }
#endif
}
```

```cpp
#include <hip/hip_runtime.h>
#include <cstdio>
#include <cstdint>

#define LAS __attribute__((address_space(3)))
#define GAS __attribute__((address_space(1)))
typedef unsigned short bf16_t;
typedef short bf16x8 __attribute__((ext_vector_type(8)));
typedef short s16x4 __attribute__((ext_vector_type(4)));
typedef float f32x4 __attribute__((ext_vector_type(4)));
typedef float f32x2 __attribute__((ext_vector_type(2)));
typedef float f32x16 __attribute__((ext_vector_type(16)));
typedef unsigned u32x4 __attribute__((ext_vector_type(4)));
typedef unsigned u32x2 __attribute__((ext_vector_type(2)));
typedef __bf16 bf16x2_t __attribute__((ext_vector_type(2)));

constexpr int DM = 1024, NBAT = 4, SEQ = 4096, DEPTH = 2, DB = 128, MIXW = 384;
constexpr int MP = NBAT * SEQ;
constexpr int MT = MP + DB;
constexpr int MPAD = 16640;
constexpr int INC = 5248, MRG = 4096, N1 = INC + MRG, N1PAD = 9472, NHB = N1 / 128;
constexpr int A_B = 0, A_C = 384, A_H = 768, A_G = 1152, S_Q = 1536, S_K = 1920, S_V = 2048, S_G = 2176,
              C_U = 2560, C_V = 2944, C_G = 3328, D_Q = 3712, D_K = 4096, D_V = 4480, D_G = 4864;
constexpr float EPS = 1e-6f;
constexpr float LOG2E = 1.4426950408889634f, LN2 = 0.6931471805599453f;

constexpr size_t O_Y = 0, O_YS = (size_t)MP * DM, O_CONVP = O_YS + (size_t)DB * DM, O_CONVS = O_CONVP + (size_t)DEPTH * NBAT * 2 * MIXW,
    O_SWAP = O_CONVS + (size_t)DEPTH * DB * 2 * MIXW, O_SWAS = O_SWAP + (size_t)DEPTH * NBAT * 128 * 256, O_D1P = O_SWAS + (size_t)DEPTH * DB * 128 * 256,
    O_D1S = O_D1P + (size_t)DEPTH * NBAT * 128 * 256, O_D4P = O_D1S + (size_t)DEPTH * DB * 128 * 256, O_D4S = O_D4P + (size_t)DEPTH * NBAT * 512 * 256,
    O_D16P = O_D4S + (size_t)DEPTH * DB * 512 * 256, O_D16S = O_D16P + (size_t)DEPTH * NBAT * 2048 * 256, O_CHV = O_D16S + (size_t)DEPTH * DB * 2048 * 256,
    O_END = O_CHV + (size_t)DEPTH * DB * MIXW;
static_assert(O_END == 207525888ull, "output size");

constexpr size_t al256(size_t x) { return (x + 255) & ~(size_t)255; }
constexpr size_t WS_CTL = 0, CTL_BYTES = 1u << 20;
constexpr size_t WS_W1T = CTL_BYTES, W1T_BYTES = (size_t)N1PAD * DM * 2;
constexpr size_t WS_WBT = WS_W1T + DEPTH * W1T_BYTES, WBT_BYTES = (size_t)4 * DM * MIXW * 2;
constexpr size_t WS_WOT = WS_WBT + DEPTH * WBT_BYTES, WOT_BYTES = (size_t)DM * DM * 2;
constexpr size_t WS_WSP = WS_WOT + DEPTH * WOT_BYTES, WSP_BYTES = (size_t)6 * 128 * 128 * 2;
constexpr size_t WS_COS = WS_WSP + DEPTH * WSP_BYTES, ROPE_BYTES = al256((size_t)4097 * 32 * 4);
constexpr size_t WS_SIN = WS_COS + ROPE_BYTES;
constexpr size_t WS_GUARD = WS_SIN + ROPE_BYTES;
constexpr size_t WS_P = WS_GUARD + (2u << 20), P_BYTES = (size_t)MPAD * INC * 2;
constexpr size_t WS_G = WS_P + P_BYTES, G_BYTES = (size_t)MPAD * MRG * 2;
constexpr size_t WS_XB = WS_G + G_BYTES, XB_BYTES = (size_t)MPAD * DM * 2;
constexpr size_t WS_X1 = WS_XB + XB_BYTES, X1_BYTES = (size_t)MPAD * DM * 4;
constexpr size_t WS_SSQ = WS_X1 + X1_BYTES, SSQ_BYTES = (size_t)MPAD * 16 * 4;
constexpr size_t WS_BR = WS_SSQ + SSQ_BYTES, BR1_BYTES = (size_t)MPAD * MIXW * 2;
constexpr size_t WS_LSE = WS_BR + 4 * BR1_BYTES, LSE_BYTES = (size_t)MPAD * 8 * 4;
constexpr size_t WS_MRG = WS_LSE + LSE_BYTES, MRGB_BYTES = (size_t)MPAD * DM * 2;
constexpr size_t WS_SCR = WS_MRG + MRGB_BYTES, SCR_BYTES = (size_t)256 * 65536 * 4;
constexpr size_t WS_END = WS_SCR + SCR_BYTES;

__device__ __forceinline__ float bf2f(unsigned short u) { return __uint_as_float((unsigned)u << 16); }
__device__ __forceinline__ float bflo(unsigned w) { return __uint_as_float(w << 16); }
__device__ __forceinline__ float bfhi(unsigned w) { return __uint_as_float(w & 0xffff0000u); }
__device__ __forceinline__ unsigned pk2(float lo, float hi) { f32x2 v = {lo, hi}; bf16x2_t b = __builtin_convertvector(v, bf16x2_t); return __builtin_bit_cast(unsigned, b); }
__device__ __forceinline__ float sigmoidf_(float x) { return __builtin_amdgcn_rcpf(1.0f + __builtin_amdgcn_exp2f(-x * LOG2E)); }
__device__ __forceinline__ float siluf_(float x) { return x * sigmoidf_(x); }
__device__ __forceinline__ float wave_sum(float v) {
#pragma unroll
    for (int o = 1; o < 64; o <<= 1) v += __shfl_xor(v, o);
    return v;
}
__device__ __forceinline__ float wave_max(float v) {
#pragma unroll
    for (int o = 1; o < 64; o <<= 1) v = fmaxf(v, __shfl_xor(v, o));
    return v;
}
__device__ __forceinline__ int crow(int r, int hi) { return (r & 3) + 8 * (r >> 2) + 4 * hi; }
__device__ __forceinline__ int fresh_lane() { int l; asm volatile("v_mbcnt_lo_u32_b32 %0, -1, 0\n\tv_mbcnt_hi_u32_b32 %0, -1, %0" : "=v"(l)); return l; }
#define LDS_WAIT() asm volatile("s_waitcnt lgkmcnt(0)" ::: "memory")
#define VM_WAIT() asm volatile("s_waitcnt vmcnt(0)" ::: "memory")

namespace pg8 {
constexpr int BM = 256, BK = 64, HALF = 128, HTB = HALF * BK * 2, STAGE_BYTES = 8 * HTB, NXCD = 8, WGM = 8;
__host__ __device__ __forceinline__ int lds_byte(int r, int c) { const int st = (r >> 4) * 2 + (c >> 5), rr = r & 15, cc = c & 31, ob = rr * 64 + cc * 2; return st * 1024 + (ob ^ (((ob >> 9) & 1) << 5)); }
__host__ __device__ __forceinline__ void stage_rc(int b, int& R, int& C) { const int st = b / 1024, sb = b % 1024, swz = sb ^ (((sb >> 9) & 1) << 5); R = (st >> 1) * 16 + swz / 64; C = (st & 1) * 32 + (swz % 64) / 2; }
__host__ __device__ __forceinline__ int perm32(int rho) { const int n = rho >> 4, i = rho & 15; return 8 * (i >> 2) + 4 * n + (i & 3); }

struct Unit { int pm, pn, sub; };
struct Gemm { const bf16_t* A; const bf16_t* Bt; int lda, ldb, K; size_t subA, subB; };

template <class Epi, class Sched, bool ALIGN_EPI, bool HALF_A = false>
__device__ __forceinline__ void gemm_phase(LAS unsigned char* lds, const int wave_id, const Gemm g, const Sched& S, Epi& E) {
    const int lane = fresh_lane(), wid = wave_id, tid = wid * 64 + lane, wr = wid >> 2, wc = wid & 3, fr = lane & 15, fq = lane >> 4;
    const int K = g.K, nt = K / BK;
    unsigned voffA[2], voffB[2];
#pragma unroll
    for (int i = 0; i < 2; ++i) { int R, C; stage_rc(tid * 16 + i * 8192, R, C); const int Rb = Epi::PERM ? ((R & ~31) + perm32(R & 31)) : R;
        voffA[i] = (unsigned)(R * g.lda + C) * 2u; voffB[i] = (unsigned)(Rb * g.ldb + C) * 2u; }
    const size_t kstep = (size_t)(BK * 2);
    const size_t hstepA = (size_t)HALF * g.lda * 2, hstepB = (size_t)HALF * g.ldb * 2;
    const size_t tstepA = HALF_A ? hstepA : 2 * hstepA, tstepB = 2 * hstepB;
    const unsigned ldsw = (unsigned)wid * 1024u;
    const int aoff = lds_byte(wr * 64 + fr, fq * 8), boff = lds_byte(wc * 32 + fr, fq * 8);
#define PG8_SA(b, h) (((b) * 2 + (h)) * HTB)
#define PG8_SB(b, h) ((4 + (b) * 2 + (h)) * HTB)
#define PG8_STAGE(bufoff, gbase, voff) do { _Pragma("unroll") for (int _i = 0; _i < 2; ++_i) \
        __builtin_amdgcn_global_load_lds((const unsigned*)((const char*)(gbase) + (voff)[_i]), (LAS unsigned*)(lds + (bufoff) + ldsw + _i * 8192), 16, 0, 0); } while (0)
#define PG8_LDA(dst, b, h) do { _Pragma("unroll") for (int m = 0; m < 4; ++m) _Pragma("unroll") for (int k = 0; k < 2; ++k) dst[m][k] = *(const LAS bf16x8*)(lds + PG8_SA(b, h) + aoff + m * 2048 + k * 1024); } while (0)
#define PG8_LDB(dst, b, h) do { _Pragma("unroll") for (int n = 0; n < 2; ++n) _Pragma("unroll") for (int k = 0; k < 2; ++k) dst[n][k] = *(const LAS bf16x8*)(lds + PG8_SB(b, h) + boff + n * 2048 + k * 1024); } while (0)
#define PG8_MMA(ai, bj, At, Bt) do { __builtin_amdgcn_s_setprio(1); _Pragma("unroll") for (int m = 0; m < 4; ++m) _Pragma("unroll") for (int n = 0; n < 2; ++n) _Pragma("unroll") for (int k = 0; k < 2; ++k) \
        acc[ai][bj][m][n] = __builtin_amdgcn_mfma_f32_16x16x32_bf16(Bt[n][k], At[m][k], acc[ai][bj][m][n], 0, 0, 0); __builtin_amdgcn_s_setprio(0); } while (0)
#define PG8_WAIT_V(n) asm volatile("s_waitcnt vmcnt(" #n ")" ::: "memory")
#define PG8_WAIT_L(n) asm volatile("s_waitcnt lgkmcnt(" #n ")" ::: "memory")
#define PG8_BAR __builtin_amdgcn_s_barrier()
#define PG8_SCHED __builtin_amdgcn_sched_barrier(0)
    Unit cur, nxt; int ui = 0;
    if (!S.next(0, cur)) return;
    f32x4 acc[2][2][4][2];
#pragma unroll
    for (int a = 0; a < 2; ++a)
#pragma unroll
        for (int b = 0; b < 2; ++b)
#pragma unroll
            for (int m = 0; m < 4; ++m)
#pragma unroll
                for (int n = 0; n < 2; ++n) acc[a][b][m][n] = (f32x4){0.f, 0.f, 0.f, 0.f};
    bf16x8 At[4][2], B0[2][2], B1[2][2];
    const char* cA = (const char*)(g.A + (size_t)cur.sub * g.subA) + (size_t)cur.pm * tstepA;
    const char* cB = (const char*)(g.Bt + (size_t)cur.sub * g.subB) + (size_t)cur.pn * tstepB;
    PG8_STAGE(PG8_SB(0, 0), cB, voffB); PG8_STAGE(PG8_SB(0, 1), cB + hstepB, voffB); PG8_STAGE(PG8_SA(0, 0), cA, voffA); PG8_STAGE(PG8_SA(0, 1), cA + hstepA, voffA);
    if (wr == 1) PG8_BAR;
    PG8_WAIT_V(2); PG8_BAR;
    PG8_STAGE(PG8_SB(1, 0), cB + kstep, voffB); PG8_STAGE(PG8_SA(1, 0), cA + kstep, voffA); PG8_STAGE(PG8_SB(1, 1), cB + hstepB + kstep, voffB);
    PG8_WAIT_V(6); PG8_BAR;
    for (;;) {
        const bool has_next = S.next(ui + 1, nxt);
        const char* nA = has_next ? (const char*)(g.A + (size_t)nxt.sub * g.subA) + (size_t)nxt.pm * tstepA : cA;
        const char* nB = has_next ? (const char*)(g.Bt + (size_t)nxt.sub * g.subB) + (size_t)nxt.pn * tstepB : cB;
#pragma nounroll
        for (int t = 0; t < nt; t += 2) {
            const bool last = (t == nt - 2);
            const char* a1 = cA + (size_t)(t + 1) * kstep;
            const char* a2 = last ? nA : cA + (size_t)(t + 2) * kstep; const char* b2 = last ? nB : cB + (size_t)(t + 2) * kstep;
            const char* a3 = a2 + kstep; const char* b3 = b2 + kstep;
            PG8_LDB(B0, 0, 0); PG8_LDB(B1, 0, 1); PG8_SCHED; PG8_LDA(At, 0, 0); PG8_STAGE(PG8_SA(1, 1), a1 + hstepA, voffA);
            PG8_WAIT_V(8); PG8_WAIT_L(0); PG8_BAR; PG8_MMA(0, 0, At, B0); PG8_MMA(0, 1, At, B1); PG8_BAR; PG8_SCHED;
            if constexpr (!HALF_A) PG8_LDA(At, 0, 1);
            PG8_STAGE(PG8_SB(0, 0), b2, voffB); PG8_STAGE(PG8_SB(0, 1), b2 + hstepB, voffB); PG8_STAGE(PG8_SA(0, 0), a2, voffA);
            PG8_WAIT_V(8); PG8_WAIT_L(0); PG8_BAR; if constexpr (!HALF_A) { PG8_MMA(1, 0, At, B0); PG8_MMA(1, 1, At, B1); } PG8_BAR; PG8_SCHED;
            PG8_LDB(B0, 1, 0); PG8_LDB(B1, 1, 1); PG8_SCHED; PG8_LDA(At, 1, 0); PG8_STAGE(PG8_SA(0, 1), a2 + hstepA, voffA);
            PG8_WAIT_V(8); PG8_WAIT_L(0); PG8_BAR; PG8_MMA(0, 0, At, B0); PG8_MMA(0, 1, At, B1); PG8_BAR; PG8_SCHED;
            if constexpr (!HALF_A) PG8_LDA(At, 1, 1);
            PG8_STAGE(PG8_SB(1, 0), b3, voffB); PG8_STAGE(PG8_SB(1, 1), b3 + hstepB, voffB); PG8_STAGE(PG8_SA(1, 0), a3, voffA);
            PG8_WAIT_V(8); PG8_WAIT_L(0); PG8_BAR; if constexpr (!HALF_A) { PG8_MMA(1, 0, At, B0); PG8_MMA(1, 1, At, B1); } PG8_BAR; PG8_SCHED;
        }
        if constexpr (ALIGN_EPI) { if (wr == 0) PG8_BAR; }
        E(acc, cur, wr, wc, fr, fq);
        if (!has_next) break;
#pragma unroll
        for (int a = 0; a < 2; ++a)
#pragma unroll
            for (int b = 0; b < 2; ++b)
#pragma unroll
                for (int m = 0; m < 4; ++m)
#pragma unroll
                    for (int n = 0; n < 2; ++n) acc[a][b][m][n] = (f32x4){0.f, 0.f, 0.f, 0.f};
        cur = nxt; cA = nA; cB = nB; ++ui;
        if constexpr (ALIGN_EPI) { if (wr == 1) PG8_BAR; }
    }
    PG8_WAIT_V(0);
    if constexpr (!ALIGN_EPI) { if (wr == 0) PG8_BAR; }
    PG8_BAR;
#undef PG8_SA
#undef PG8_SB
#undef PG8_STAGE
#undef PG8_LDA
#undef PG8_LDB
#undef PG8_MMA
#undef PG8_WAIT_V
#undef PG8_WAIT_L
#undef PG8_BAR
#undef PG8_SCHED
}
}
using pg8::Unit;

struct SchedG1 {
    int nM, nN, nwg, G, c;
    __device__ __forceinline__ bool next(int i, Unit& u) const {
        const long L = (long)i * G + c; if (L >= nwg) return false;
        int wgid = (int)L; { const int q = nwg / 8, r = nwg % 8, xcd = wgid % 8, off = wgid / 8; wgid = (xcd < r ? xcd * (q + 1) : r * (q + 1) + (xcd - r) * q) + off; }
        const int nig = 8 * nN, gid = wgid / nig, fm = gid * 8, gsz = (nM - fm) < 8 ? (nM - fm) : 8;
        u.pm = fm + ((wgid % nig) % gsz); u.pn = (wgid % nig) / gsz; u.sub = 0; return true;
    }
};
struct SchedSub {
    int vcu, G, nsub, ntiles;
    __device__ __forceinline__ bool next(int i, Unit& u) const {
        const int j = i / nsub, q = vcu + j * G; if (q >= ntiles) return false;
        u.pm = q >> 2; u.pn = q & 3; u.sub = i - j * nsub; return true;
    }
};

__device__ __forceinline__ int perm_row(int row, int lg) {
    if (lg == 0 || row >= MP) return row;
    const int t = row & (SEQ - 1), d1 = (1 << lg) - 1;
    return (row & ~(SEQ - 1)) + (t & d1) * (SEQ >> lg) + (t >> lg);
}
struct EpiG1 {
    static constexpr bool PERM = true;
    bf16_t* P; bf16_t* Gt; const float* ssq; const float* cosT; const float* sinT;
    __device__ __forceinline__ void operator()(const f32x4 (&acc)[2][2][4][2], const Unit& u, int wr, int wc, int fr, int fq) const {
        float rs[2][4];
#pragma unroll
        for (int ai = 0; ai < 2; ++ai)
#pragma unroll
            for (int m = 0; m < 4; ++m) { const int row = u.pm * 256 + ai * 128 + wr * 64 + m * 16 + fr;
                const f32x4 p = *(const f32x4*)(ssq + (size_t)row * 16 + 4 * fq); float s = (p.x + p.y) + (p.z + p.w);
                s += __shfl_xor(s, 16); s += __shfl_xor(s, 32); rs[ai][m] = rsqrtf(s * (1.0f / DM) + EPS); }
#pragma unroll
        for (int bj = 0; bj < 2; ++bj) {
            const int hb = 2 * u.pn + bj; if (hb >= NHB) continue;
            const int ch = 32 * wc + 8 * fq;
            if (hb >= 41) {
#pragma unroll
                for (int ai = 0; ai < 2; ++ai)
#pragma unroll
                    for (int m = 0; m < 4; ++m) { const int row = u.pm * 256 + ai * 128 + wr * 64 + m * 16 + fr; const float r = rs[ai][m];
                        const f32x4 v0 = acc[ai][bj][m][0] * r, v1 = acc[ai][bj][m][1] * r; u32x4 w;
                        w.x = pk2(sigmoidf_(v0.x), sigmoidf_(v0.y)); w.y = pk2(sigmoidf_(v0.z), sigmoidf_(v0.w)); w.z = pk2(sigmoidf_(v1.x), sigmoidf_(v1.y)); w.w = pk2(sigmoidf_(v1.z), sigmoidf_(v1.w));
                        *(u32x4*)(Gt + (size_t)row * MRG + (hb - 41) * 128 + ch) = w; }
            } else {
                const bool rope = (hb >= 12 && hb < 16) || (hb >= 29 && hb < 35);
                const int lg = (hb >= 29) ? 2 * ((hb - 29) % 3) : 0;
                if (rope) {
                    const int d0 = 16 * (wc & 1) + 4 * fq, hbase = hb * 128 + 64 * (wc >> 1);
#pragma unroll
                    for (int ai = 0; ai < 2; ++ai) {
                        f32x4 cs[4], sn[4];
#pragma unroll
                        for (int m = 0; m < 4; ++m) { const int row = u.pm * 256 + ai * 128 + wr * 64 + m * 16 + fr; const int pi = row < MP ? (row & (SEQ - 1)) : SEQ;
                            cs[m] = *(const f32x4*)(cosT + pi * 32 + d0); sn[m] = *(const f32x4*)(sinT + pi * 32 + d0); }
#pragma unroll
                        for (int m = 0; m < 4; ++m) { const int row = u.pm * 256 + ai * 128 + wr * 64 + m * 16 + fr; const float r = rs[ai][m];
                            const f32x4 c = cs[m], s = sn[m];
                            const f32x4 x1 = acc[ai][bj][m][0] * r, x2 = acc[ai][bj][m][1] * r;
                            const f32x4 o1 = x1 * c - x2 * s, o2 = x2 * c + x1 * s;
                            bf16_t* dst = P + (size_t)perm_row(row, lg) * INC + hbase + d0;
                            u32x2 w1, w2; w1.x = pk2(o1.x, o1.y); w1.y = pk2(o1.z, o1.w); w2.x = pk2(o2.x, o2.y); w2.y = pk2(o2.z, o2.w);
                            *(u32x2*)dst = w1; *(u32x2*)(dst + 32) = w2; }
                    }
                } else {
#pragma unroll
                    for (int ai = 0; ai < 2; ++ai)
#pragma unroll
                        for (int m = 0; m < 4; ++m) { const int row = u.pm * 256 + ai * 128 + wr * 64 + m * 16 + fr; const float r = rs[ai][m];
                            const f32x4 v0 = acc[ai][bj][m][0] * r, v1 = acc[ai][bj][m][1] * r; u32x4 w;
                            w.x = pk2(v0.x, v0.y); w.y = pk2(v0.z, v0.w); w.z = pk2(v1.x, v1.y); w.w = pk2(v1.z, v1.w);
                            *(u32x4*)(P + (size_t)perm_row(row, lg) * INC + hb * 128 + ch) = w; }
                }
            }
        }
    }
};
struct EpiG2 {
    static constexpr bool PERM = true;
    const bf16_t* Gt; bf16_t* mrg; f32x4 mg[2][4][2];
    __device__ __forceinline__ void init() {
#pragma unroll
        for (int b = 0; b < 2; ++b)
#pragma unroll
            for (int m = 0; m < 4; ++m)
#pragma unroll
                for (int n = 0; n < 2; ++n) mg[b][m][n] = (f32x4){0.f, 0.f, 0.f, 0.f};
    }
    __device__ __forceinline__ void operator()(const f32x4 (&acc)[2][2][4][2], const Unit& u, int wr, int wc, int fr_, int fq_) {
        const int lane = fresh_lane(), fr = lane & 15, fq = lane >> 4;
        u32x4 gw[4][2];
#pragma unroll
        for (int m = 0; m < 4; ++m) { const unsigned row = u.pm * 128 + wr * 64 + m * 16 + fr;
#pragma unroll
            for (int bj = 0; bj < 2; ++bj) gw[m][bj] = *(const u32x4*)((const char*)Gt + (row * (unsigned)MRG + (unsigned)u.sub * DM + u.pn * 256 + bj * 128 + wc * 32 + fq * 8) * 2u); }
#pragma unroll
        for (int m = 0; m < 4; ++m)
#pragma unroll
            for (int bj = 0; bj < 2; ++bj) { const u32x4 g = gw[m][bj]; const f32x4 a0 = acc[0][bj][m][0], a1 = acc[0][bj][m][1];
                mg[bj][m][0].x += a0.x * bflo(g.x); mg[bj][m][0].y += a0.y * bfhi(g.x); mg[bj][m][0].z += a0.z * bflo(g.y); mg[bj][m][0].w += a0.w * bfhi(g.y);
                mg[bj][m][1].x += a1.x * bflo(g.z); mg[bj][m][1].y += a1.y * bfhi(g.z); mg[bj][m][1].z += a1.z * bflo(g.w); mg[bj][m][1].w += a1.w * bfhi(g.w); }
        if (u.sub == 3) {
#pragma unroll
            for (int m = 0; m < 4; ++m) { const unsigned row = u.pm * 128 + wr * 64 + m * 16 + fr;
#pragma unroll
                for (int bj = 0; bj < 2; ++bj) { const f32x4 v0 = mg[bj][m][0], v1 = mg[bj][m][1]; u32x4 w;
                    w.x = pk2(v0.x, v0.y); w.y = pk2(v0.z, v0.w); w.z = pk2(v1.x, v1.y); w.w = pk2(v1.z, v1.w);
                    *(u32x4*)((char*)mrg + (row * (unsigned)DM + u.pn * 256 + bj * 128 + wc * 32 + fq * 8) * 2u) = w; } }
            init();
        }
    }
};
struct EpiG3 {
    static constexpr bool PERM = false;
    const float* xold; float* xnew; bf16_t* xb; float* ssq;
    __device__ __forceinline__ void operator()(const f32x4 (&acc)[2][2][4][2], const Unit& u, int wr, int wc, int fr, int fq) const {
#pragma unroll
        for (int ai = 0; ai < 2; ++ai) {
            f32x4 xo[4][2][2];
#pragma unroll
            for (int m = 0; m < 4; ++m) { const int row = u.pm * 256 + ai * 128 + wr * 64 + m * 16 + fr;
#pragma unroll
                for (int bj = 0; bj < 2; ++bj)
#pragma unroll
                    for (int n = 0; n < 2; ++n) xo[m][bj][n] = *(const f32x4*)(xold + (size_t)row * DM + u.pn * 256 + bj * 128 + wc * 32 + n * 16 + fq * 4); }
#pragma unroll
            for (int m = 0; m < 4; ++m) { const int row = u.pm * 256 + ai * 128 + wr * 64 + m * 16 + fr; float sq = 0.f;
#pragma unroll
                for (int bj = 0; bj < 2; ++bj)
#pragma unroll
                    for (int n = 0; n < 2; ++n) { const size_t off = (size_t)row * DM + u.pn * 256 + bj * 128 + wc * 32 + n * 16 + fq * 4;
                        const f32x4 xn = xo[m][bj][n] + acc[ai][bj][m][n];
                        *(f32x4*)(xnew + off) = xn; u32x2 w; w.x = pk2(xn.x, xn.y); w.y = pk2(xn.z, xn.w); *(u32x2*)(xb + off) = w;
                        sq += (xn.x * xn.x + xn.y * xn.y) + (xn.z * xn.z + xn.w * xn.w); }
                sq += __shfl_xor(sq, 16); sq += __shfl_xor(sq, 32);
                if (fq == 0) ssq[(size_t)row * 16 + u.pn * 4 + wc] = sq; }
        }
    }
};
template <bool P> struct EpiNull {
    static constexpr bool PERM = P;
    __device__ __forceinline__ void operator()(const f32x4 (&acc)[2][2][4][2], const Unit& u, int wr, int wc, int fr, int fq) const {
#pragma unroll
        for (int a = 0; a < 2; ++a)
#pragma unroll
            for (int b = 0; b < 2; ++b)
#pragma unroll
                for (int m = 0; m < 4; ++m)
#pragma unroll
                    for (int n = 0; n < 2; ++n) asm volatile("" :: "v"(acc[a][b][m][n]));
    }
};
typedef GAS unsigned gu32;
#define RLX_AGENT __ATOMIC_RELAXED, __HIP_MEMORY_SCOPE_AGENT
__device__ __forceinline__ unsigned xb_ld(unsigned* p)              { return __hip_atomic_load(p, __ATOMIC_RELAXED, __HIP_MEMORY_SCOPE_AGENT); }
__device__ __forceinline__ unsigned xb_add(unsigned* p, unsigned v) { return __hip_atomic_fetch_add(p, v, __ATOMIC_RELAXED, __HIP_MEMORY_SCOPE_AGENT); }
#define FB_WORD(j) (3520 + 64 * (j))
__device__ __forceinline__ void flat_barrier(unsigned* bar, unsigned seq) {
    asm volatile("s_waitcnt vmcnt(0)" ::: "memory");
    __syncthreads();
    if (threadIdx.x < 64) {
        const int lane = threadIdx.x;
        if (lane == 0) {
            __builtin_amdgcn_fence(__ATOMIC_RELEASE, "agent");
            asm volatile("s_waitcnt vmcnt(0)" ::: "memory");
            (void)xb_add(&bar[FB_WORD(blockIdx.x & 7)], 1u);
        }
        const unsigned target = seq * gridDim.x;
        unsigned sp = 0;
        for (;;) {
            unsigned v = (lane < 8) ? xb_ld(&bar[FB_WORD(lane)]) : 0u;
#pragma unroll
            for (int o = 1; o < 8; o <<= 1) v += __shfl_xor(v, o);
            v = __builtin_amdgcn_readfirstlane(v);
            if (v >= target) break;
            __builtin_amdgcn_s_sleep(1);
            if (++sp > (1u << 20)) break;
        }
        if (lane == 0) { __builtin_amdgcn_fence(__ATOMIC_ACQUIRE, "agent"); asm volatile("s_waitcnt vmcnt(0)" ::: "memory"); }
    }
    __syncthreads();
}

constexpr int NWAVES = 8, NTHR = 512;
constexpr int RING_BYTES = 131072, MISC_OFF = RING_BYTES + 320, LDS_BYTES = 147456;
constexpr int CW_BAR = 4096;

struct Args {
    const float* in[19]; float* out; unsigned char* ws; int ph_lo, ph_hi;
};
#define CAS __attribute__((address_space(4)))
struct Frame {
    LAS unsigned char* lds;
    int wave, vcu, G;
    __device__ __forceinline__ const CAS Args* ap() const { const CAS Args* p = (const CAS Args*)__builtin_amdgcn_kernarg_segment_ptr(); asm volatile("" : "+s"(p)); return p; }
    __device__ __forceinline__ const float* in(int i) const { return ap()->in[i]; }
    __device__ __forceinline__ float* out() const { return ap()->out; }
    __device__ __forceinline__ unsigned char* ws() const { return ap()->ws; }
    __device__ __forceinline__ int lane() const { return fresh_lane(); }
    __device__ __forceinline__ int tid() const { return wave * 64 + fresh_lane(); }
};
enum { I_XP = 0, I_XS, I_SCONV, I_CSWA, I_CD1, I_CD4, I_CD16, I_NG, I_WIN, I_CONVW, I_SINK, I_LNG, I_LNB, I_WSP, I_BSP, I_WBR, I_WMG, I_WOUT, I_FNG };

template <class CMap>
__device__ __forceinline__ void transpose_item(const float* W, int ldw, const float* kscale, bf16_t* WT, int ldwt, int k0, int n0, LAS float* scr, int lane, const CMap& cmap) {
    const int sc = cmap(n0 + (lane & 31));
#pragma unroll 8
    for (int i = 0; i < 32; ++i) { const int kk = 2 * i + (lane >> 5); float v = W[(size_t)(k0 + kk) * ldw + sc]; if (kscale) v *= kscale[k0 + kk]; scr[kk * 33 + (lane & 31)] = v; }
    LDS_WAIT(); asm volatile("" ::: "memory");
    const int c = lane & 7;
#pragma unroll
    for (int j = 0; j < 4; ++j) { const int n = (lane >> 3) + 8 * j; const LAS float* s = scr + (8 * c) * 33 + n;
        u32x4 o; o.x = pk2(s[0 * 33], s[1 * 33]); o.y = pk2(s[2 * 33], s[3 * 33]); o.z = pk2(s[4 * 33], s[5 * 33]); o.w = pk2(s[6 * 33], s[7 * 33]);
        *(u32x4*)(WT + (size_t)(n0 + n) * ldwt + k0 + 8 * c) = o; }
    LDS_WAIT(); asm volatile("" ::: "memory");
}
struct CMapId { int off; __device__ __forceinline__ int operator()(int n) const { return n - off; } };
struct CMapIn {
    __device__ __forceinline__ int operator()(int p) const {
        const int hb = p >> 7; const bool rope = (hb >= 12 && hb < 16) || (hb >= 29 && hb < 35);
        if (!rope) return p;
        const int w = p & 63, j = w >> 3, n = (w >> 2) & 1, i = w & 3; return (p & ~63) + 4 * j + i + 32 * n;
    }
};
__device__ __forceinline__ void cache_shift_copy(Frame& F, const float* src, float* dst, int nrows, int gt, int GT) {
    const size_t nvec = (size_t)DEPTH * DB * nrows * 64;
    const f32x4* s4 = (const f32x4*)src; f32x4* d4 = (f32x4*)dst;
    for (size_t v0 = (size_t)gt; v0 < nvec; v0 += (size_t)GT * 16) {
        f32x4 t[16]; bool ok[16];
#pragma unroll
        for (int k = 0; k < 16; ++k) { const size_t v = v0 + (size_t)k * GT; const bool in = v < nvec; ok[k] = in && (int)((v >> 6) % nrows) != nrows - 1;
            t[k] = __builtin_nontemporal_load(s4 + (ok[k] ? v + 64 : (size_t)gt)); }
#pragma unroll
        for (int k = 0; k < 16; ++k) { const size_t v = v0 + (size_t)k * GT; if (ok[k]) __builtin_nontemporal_store(t[k], d4 + v); }
    }
}
__device__ __forceinline__ void p0_prologue(Frame& F) {
    const int lane_ = F.lane(), tid_ = F.wave * 64 + lane_; (void)tid_;
    LAS float* scr = (LAS float*)(F.lds + F.wave * 16384);
    const int gw = F.vcu * NWAVES + F.wave, NGW = F.G * NWAVES;
    constexpr int I_W1 = (DM / 64) * (N1PAD / 32), I_WB = (MIXW / 64) * (DM / 32), I_WO = (DM / 64) * (DM / 32);
    constexpr int NITEMS = DEPTH * (I_W1 + 4 * I_WB + I_WO);
    for (int it = gw; it < NITEMS; it += NGW) {
        int r = it; const int l = r / (I_W1 + 4 * I_WB + I_WO); r -= l * (I_W1 + 4 * I_WB + I_WO);
        if (r < I_W1) {
            const int nblk = N1PAD / 32, kb = r / nblk, nb = r % nblk, n0 = nb * 32, k0 = kb * 64;
            bf16_t* WT = (bf16_t*)(F.ws() + WS_W1T + l * W1T_BYTES);
            const float* ng = F.in(I_NG) + l * DM;
            if (n0 < INC) transpose_item(F.in(I_WIN) + (size_t)l * DM * INC, INC, ng, WT, DM, k0, n0, scr, lane_, CMapIn{});
            else if (n0 < N1) transpose_item(F.in(I_WMG) + (size_t)l * DM * MRG, MRG, ng, WT, DM, k0, n0, scr, lane_, CMapId{INC});
            else { const int c = lane_ & 7;
#pragma unroll
                for (int j = 0; j < 4; ++j) { const int n = (lane_ >> 3) + 8 * j; *(u32x4*)(WT + (size_t)(n0 + n) * DM + k0 + 8 * c) = (u32x4){0u, 0u, 0u, 0u}; } }
            continue;
        }
        r -= I_W1;
        if (r < 4 * I_WB) {
            const int n = r / I_WB, rr = r % I_WB, nblk = DM / 32, kb = rr / nblk, nb = rr % nblk;
            transpose_item(F.in(I_WBR) + ((size_t)l * 4 + n) * MIXW * DM, DM, nullptr, (bf16_t*)(F.ws() + WS_WBT + l * WBT_BYTES) + (size_t)n * DM * MIXW, MIXW, kb * 64, nb * 32, scr, lane_, CMapId{0});
            continue;
        }
        r -= 4 * I_WB;
        { const int nblk = DM / 32, kb = r / nblk, nb = r % nblk;
          transpose_item(F.in(I_WOUT) + (size_t)l * DM * DM, DM, nullptr, (bf16_t*)(F.ws() + WS_WOT + l * WOT_BYTES), DM, kb * 64, nb * 32, scr, lane_, CMapId{0}); }
    }
    const int gt = F.vcu * NTHR + tid_, GT = F.G * NTHR;
    for (int e = gt; e < DEPTH * 6 * 128 * 128; e += GT) { const int s = e & 127, t = (e >> 7) & 127; const float v = F.in(I_WSP)[e];
        ((bf16_t*)(F.ws() + WS_WSP))[e] = (bf16_t)(pk2(s <= t ? v : 0.f, 0.f) & 0xffffu); }
    for (int e = gt; e < 4097 * 32; e += GT) { const int pi = e >> 5, i = e & 31; const double pos = pi < SEQ ? (double)pi : 16384.0;
        const float inv = powf(10000.0f, -(float)i / 32.0f); const float ang = (float)pos * inv;
        ((float*)(F.ws() + WS_COS))[e] = (float)cos((double)ang); ((float*)(F.ws() + WS_SIN))[e] = (float)sin((double)ang); }
    for (int m = gw; m < MPAD; m += NGW) {
        bf16_t* xbr = (bf16_t*)(F.ws() + WS_XB) + (size_t)m * DM; float* sq = (float*)(F.ws() + WS_SSQ) + (size_t)m * 16;
        if (m < MT) {
            const float* xr = m < MP ? F.in(I_XP) + (size_t)m * DM : F.in(I_XS) + (size_t)(m - MP) * DM;
            f32x4 v[4]; float s = 0.f;
#pragma unroll
            for (int j = 0; j < 4; ++j) { v[j] = ((const f32x4*)xr)[lane_ + 64 * j]; s += (v[j].x * v[j].x + v[j].y * v[j].y) + (v[j].z * v[j].z + v[j].w * v[j].w); }
            s = wave_sum(s);
#pragma unroll
            for (int j = 0; j < 4; ++j) { u32x2 w; w.x = pk2(v[j].x, v[j].y); w.y = pk2(v[j].z, v[j].w); ((u32x2*)xbr)[lane_ + 64 * j] = w; }
            if (lane_ < 16) sq[lane_] = lane_ == 0 ? s : 0.f;
        } else {
#pragma unroll
            for (int j = 0; j < 4; ++j) ((u32x2*)xbr)[lane_ + 64 * j] = (u32x2){0u, 0u};
            if (lane_ < 16) sq[lane_] = lane_ == 0 ? (float)DM : 0.f;
        }
    }
    cache_shift_copy(F, F.in(I_CSWA), F.out() + O_SWAS, 128, gt, GT);
    cache_shift_copy(F, F.in(I_CD1), F.out() + O_D1S, 128, gt, GT);
    cache_shift_copy(F, F.in(I_CD4), F.out() + O_D4S, 512, gt, GT);
    cache_shift_copy(F, F.in(I_CD16), F.out() + O_D16S, 2048, gt, GT);
}

struct AttDesc {
    int R0, nb;
    int colK, colV;
    int colQ, colG, outcol, qstride;
    bf16_t* out;
    int orow0, ostride;
    const float* sinks;
    float* lse; int lsecol;
};
__device__ __forceinline__ void att_unit(Frame& F, const AttDesc& D) {
    const bf16_t* P = (const bf16_t*)(F.ws() + WS_P);
    LAS unsigned char* lds = F.lds;
    const int lane = F.lane(), wid = F.wave, tid = wid * 64 + lane, slot = wid >> 2, w = wid & 3, ql = lane & 31, hi = lane >> 5;
    const int qrow = D.R0 + 32 * w + ql;
    const int orow = D.orow0 + (32 * w + ql) * D.ostride;
    u32x4 stK[2][4], stV[2][4];
#pragma unroll
    for (int s = 0; s < 2; ++s)
#pragma unroll
        for (int it = 0; it < 4; ++it) {
            const int idx = tid + 512 * it, rr = (D.nb == 0 && it < 2) ? 128 + (idx >> 3) : (idx >> 3), ch = idx & 7;
            const bf16_t* src = P + (size_t)(D.R0 - 128 + rr) * INC + ch * 8;
            stK[s][it] = *(const u32x4*)(src + D.colK + 64 * s); stV[s][it] = *(const u32x4*)(src + D.colV + 64 * s);
        }
    bf16x8 qf[4];
#pragma unroll
    for (int d0 = 0; d0 < 4; ++d0) qf[d0] = *(const bf16x8*)(P + (size_t)qrow * INC + D.colQ + D.qstride * slot + 16 * d0 + 8 * hi);
    u32x2 gw[2][4];
    { const bf16_t* gp = P + (size_t)qrow * INC + D.colG + D.qstride * slot;
#pragma unroll
      for (int db = 0; db < 2; ++db)
#pragma unroll
        for (int rg = 0; rg < 4; ++rg) gw[db][rg] = *(const u32x2*)(gp + 32 * db + 8 * rg + 4 * hi); }
    float sk2 = 0.f; if (D.sinks) sk2 = D.sinks[3 * slot] * LOG2E;
    __syncthreads();
#pragma unroll
    for (int s = 0; s < 2; ++s)
#pragma unroll
        for (int it = 0; it < 4; ++it) {
            if (D.nb == 0 && it < 2) continue;
            const int idx = tid + 512 * it, rr = idx >> 3, ch = idx & 7;
            *(LAS u32x4*)(lds + s * 65536 + rr * 128 + ((ch ^ (rr & 7)) << 4)) = stK[s][it];
            *(LAS u32x4*)(lds + s * 65536 + 32768 + rr * 128 + ((ch ^ (((rr >> 1) & 1) << 2)) << 4)) = stV[s][it];
        }
    __syncthreads();
    const LAS unsigned char* Kb = lds + slot * 65536; const LAS unsigned char* Vb = Kb + 32768;
    const int i16 = lane & 15, q4 = i16 >> 2, p4 = i16 & 3, blk = (lane >> 4) & 1;
    const int c0 = (D.nb == 0) ? (4 - w) : 0;
    f32x16 S[5];
#pragma unroll
    for (int c = 0; c < 5; ++c) {
#pragma unroll
        for (int r = 0; r < 16; ++r) S[c][r] = 0.f;
        if (c >= c0) {
            const int row = 32 * (w + c) + ql;
#pragma unroll
            for (int d0 = 0; d0 < 4; ++d0) { const bf16x8 kf = *(const LAS bf16x8*)(Kb + row * 128 + (((2 * d0 + hi) ^ (row & 7)) << 4));
                S[c] = __builtin_amdgcn_mfma_f32_32x32x16_bf16(kf, qf[d0], S[c], 0, 0, 0); }
        }
    }
    const float sc = 0.125f * LOG2E; float mx = -1e30f;
#pragma unroll
    for (int c = 0; c < 5; ++c)
#pragma unroll
        for (int r = 0; r < 16; ++r) { const int kr = crow(r, hi);
            const bool valid = (c >= c0) && (c != 0 || kr >= ql) && (c != 4 || kr <= ql);
            const float s = valid ? S[c][r] * sc : -1e30f; S[c][r] = s; mx = fmaxf(mx, s); }
    mx = fmaxf(mx, __shfl_xor(mx, 32));
    if (D.sinks) mx = fmaxf(mx, sk2);
    float den = 0.f;
#pragma unroll
    for (int c = 0; c < 5; ++c)
#pragma unroll
        for (int r = 0; r < 16; ++r) { const float p = __builtin_amdgcn_exp2f(S[c][r] - mx); S[c][r] = p; den += p; }
    den += __shfl_xor(den, 32);
    if (D.sinks) den += __builtin_amdgcn_exp2f(sk2 - mx);
    const float inv = 1.0f / den;
    f32x16 OT[2];
#pragma unroll
    for (int r = 0; r < 16; ++r) { OT[0][r] = 0.f; OT[1][r] = 0.f; }
#pragma unroll
    for (int c = 0; c < 5; ++c) {
        if (c >= c0) {
#pragma unroll
            for (int ks = 0; ks < 2; ++ks) {
                u32x4 pw; pw.x = pk2(S[c][8 * ks + 0], S[c][8 * ks + 1]); pw.y = pk2(S[c][8 * ks + 2], S[c][8 * ks + 3]); pw.z = pk2(S[c][8 * ks + 4], S[c][8 * ks + 5]); pw.w = pk2(S[c][8 * ks + 6], S[c][8 * ks + 7]);
                const bf16x8 pf = __builtin_bit_cast(bf16x8, pw);
                const int r0 = 32 * (w + c) + 16 * ks + 4 * hi + q4, r1 = r0 + 8;
#pragma unroll
                for (int db = 0; db < 2; ++db) { const int chk = 4 * db + 2 * blk + (p4 >> 1), wi = 8 * (p4 & 1);
                    const s16x4 lo = __builtin_bit_cast(s16x4, __builtin_amdgcn_ds_read_tr16_b64_v4i16((LAS s16x4*)(Vb + r0 * 128 + ((chk ^ (((r0 >> 1) & 1) << 2)) << 4) + wi)));
                    const s16x4 hh = __builtin_bit_cast(s16x4, __builtin_amdgcn_ds_read_tr16_b64_v4i16((LAS s16x4*)(Vb + r1 * 128 + ((chk ^ (((r1 >> 1) & 1) << 2)) << 4) + wi)));
                    const bf16x8 vf = __builtin_shufflevector(lo, hh, 0, 1, 2, 3, 4, 5, 6, 7);
                    OT[db] = __builtin_amdgcn_mfma_f32_32x32x16_bf16(vf, pf, OT[db], 0, 0, 0); }
            }
        }
    }
    if (D.lse && hi == 0) D.lse[(size_t)orow * 8 + D.lsecol + slot] = (mx + __builtin_amdgcn_logf(den)) * LN2;
    bf16_t* op = D.out + (size_t)orow * MIXW + D.outcol + D.qstride * slot;
#pragma unroll
    for (int db = 0; db < 2; ++db)
#pragma unroll
        for (int rg = 0; rg < 4; ++rg) { const int d = 32 * db + 8 * rg + 4 * hi; const u32x2 g = gw[db][rg];
            const float o0 = OT[db][4 * rg + 0] * inv * siluf_(bflo(g.x)), o1 = OT[db][4 * rg + 1] * inv * siluf_(bfhi(g.x)),
                        o2 = OT[db][4 * rg + 2] * inv * siluf_(bflo(g.y)), o3 = OT[db][4 * rg + 3] * inv * siluf_(bfhi(g.y));
            u32x2 ow; ow.x = pk2(o0, o1); ow.y = pk2(o2, o3); *(u32x2*)(op + d) = ow; }
}

__device__ __forceinline__ void spatial_unit(Frame& F, int l, int R0) {
    const bf16_t* P = (const bf16_t*)(F.ws() + WS_P);
    bf16_t* BrC = (bf16_t*)(F.ws() + WS_BR + 2 * BR1_BYTES);
    const bf16_t* Wsp = (const bf16_t*)(F.ws() + WS_WSP + l * WSP_BYTES);
    LAS unsigned char* lds = F.lds;
    const int lane = F.lane(), wid = F.wave, ql = lane & 31, hi = lane >> 5;
    { const int tk = lane >> 4, sub = lane & 15;
      u32x4 xv[4][3];
#pragma unroll
      for (int it = 0; it < 4; ++it)
#pragma unroll
        for (int i = 0; i < 3; ++i) xv[it][i] = *(const u32x4*)(P + (size_t)(R0 + 16 * wid + 4 * it + tk) * INC + C_V + 8 * (sub + 16 * i));
      f32x4 gg[3][2], bb[3][2];
      { const float* lg = F.in(I_LNG) + l * MIXW; const float* lb = F.in(I_LNB) + l * MIXW;
#pragma unroll
        for (int i = 0; i < 3; ++i)
#pragma unroll
          for (int h = 0; h < 2; ++h) { gg[i][h] = *(const f32x4*)(lg + 8 * (sub + 16 * i) + 4 * h); bb[i][h] = *(const f32x4*)(lb + 8 * (sub + 16 * i) + 4 * h); } }
      __syncthreads();
#pragma unroll
      for (int it = 0; it < 4; ++it) { const int t = 16 * wid + 4 * it + tk;
        f32x4 x[3][2]; float s = 0.f;
#pragma unroll
        for (int i = 0; i < 3; ++i) { const u32x4 v = xv[it][i]; x[i][0] = (f32x4){bflo(v.x), bfhi(v.x), bflo(v.y), bfhi(v.y)}; x[i][1] = (f32x4){bflo(v.z), bfhi(v.z), bflo(v.w), bfhi(v.w)};
            s += ((x[i][0].x + x[i][0].y) + (x[i][0].z + x[i][0].w)) + ((x[i][1].x + x[i][1].y) + (x[i][1].z + x[i][1].w)); }
#pragma unroll
        for (int o = 1; o < 16; o <<= 1) s += __shfl_xor(s, o);
        const float mu = s * (1.0f / MIXW); float q = 0.f;
#pragma unroll
        for (int i = 0; i < 3; ++i)
#pragma unroll
          for (int h = 0; h < 2; ++h) { x[i][h] = x[i][h] - mu; q += (x[i][h].x * x[i][h].x + x[i][h].y * x[i][h].y) + (x[i][h].z * x[i][h].z + x[i][h].w * x[i][h].w); }
#pragma unroll
        for (int o = 1; o < 16; o <<= 1) q += __shfl_xor(q, o);
        const float rstd = rsqrtf(q * (1.0f / MIXW) + EPS);
#pragma unroll
        for (int i = 0; i < 3; ++i) { const f32x4 y0 = x[i][0] * rstd * gg[i][0] + bb[i][0], y1 = x[i][1] * rstd * gg[i][1] + bb[i][1];
            u32x4 o; o.x = pk2(y0.x, y0.y); o.y = pk2(y0.z, y0.w); o.z = pk2(y1.x, y1.y); o.w = pk2(y1.z, y1.w);
            const int chn = sub + 16 * i;
            *(LAS u32x4*)(lds + t * 768 + (chn >> 3) * 128 + (((chn & 7) ^ (((t >> 1) & 1) << 2)) << 4)) = o; } }
    }
    __syncthreads();
    const int i16 = lane & 15, q4 = i16 >> 2, p4 = i16 & 3, blk = (lane >> 4) & 1;
    const float* bsp = F.in(I_BSP) + l * 6 * 128;
    for (int pr = wid; pr < 24; pr += 8) {
        const int tb = pr & 3, g = pr >> 2;
        const int t = 32 * tb + ql;
        const bf16_t* wrow = Wsp + ((size_t)g * 128 + t) * 128;
        bf16x8 wf[8];
#pragma unroll
        for (int ks = 0; ks < 8; ++ks) wf[ks] = *(const bf16x8*)(wrow + 16 * ks + 8 * hi);
        const bf16_t* up = P + (size_t)(R0 + t) * INC + C_U + 64 * g; const bf16_t* gp = P + (size_t)(R0 + t) * INC + C_G + 64 * g;
        u32x2 uw[2][4], gw[2][4];
#pragma unroll
        for (int db = 0; db < 2; ++db)
#pragma unroll
            for (int rg = 0; rg < 4; ++rg) { const int d = 32 * db + 8 * rg + 4 * hi; uw[db][rg] = *(const u32x2*)(up + d); gw[db][rg] = *(const u32x2*)(gp + d); }
        const float bias = bsp[g * 128 + t];
        bf16_t* op = BrC + (size_t)(R0 + t) * MIXW + 64 * g;
#pragma unroll
        for (int db = 0; db < 2; ++db) {
            f32x16 acc;
#pragma unroll
            for (int r = 0; r < 16; ++r) acc[r] = 0.f;
            const int chk = 4 * db + 2 * blk + (p4 >> 1), wi = 8 * (p4 & 1);
#pragma unroll
            for (int ks = 0; ks < 8; ++ks) {
                if (ks < 2 * (tb + 1)) {
                    const int r0 = 16 * ks + 8 * hi + q4, r1 = r0 + 4;
                    const s16x4 lo = __builtin_bit_cast(s16x4, __builtin_amdgcn_ds_read_tr16_b64_v4i16((LAS s16x4*)(lds + r0 * 768 + g * 128 + ((chk ^ (((r0 >> 1) & 1) << 2)) << 4) + wi)));
                    const s16x4 hh = __builtin_bit_cast(s16x4, __builtin_amdgcn_ds_read_tr16_b64_v4i16((LAS s16x4*)(lds + r1 * 768 + g * 128 + ((chk ^ (((r1 >> 1) & 1) << 2)) << 4) + wi)));
                    const bf16x8 vf = __builtin_shufflevector(lo, hh, 0, 1, 2, 3, 4, 5, 6, 7);
                    acc = __builtin_amdgcn_mfma_f32_32x32x16_bf16(vf, wf[ks], acc, 0, 0, 0);
                }
            }
#pragma unroll
            for (int rg = 0; rg < 4; ++rg) { const int d = 32 * db + 8 * rg + 4 * hi; const u32x2 u2 = uw[db][rg], g2 = gw[db][rg];
                const float o0 = bflo(u2.x) * (acc[4 * rg + 0] + bias) * siluf_(bflo(g2.x)), o1 = bfhi(u2.x) * (acc[4 * rg + 1] + bias) * siluf_(bfhi(g2.x)),
                            o2 = bflo(u2.y) * (acc[4 * rg + 2] + bias) * siluf_(bflo(g2.y)), o3 = bfhi(u2.y) * (acc[4 * rg + 3] + bias) * siluf_(bfhi(g2.y));
                u32x2 ow; ow.x = pk2(o0, o1); ow.y = pk2(o2, o3); *(u32x2*)(op + d) = ow; }
        }
    }
}

__device__ __forceinline__ void conv_unit(Frame& F, int l, int b, int t0) {
    const int lane_ = F.lane(), tid_ = F.wave * 64 + lane_;
    const bf16_t* P = (const bf16_t*)(F.ws() + WS_P);
    bf16_t* BrA = (bf16_t*)(F.ws() + WS_BR);
    const float* cw = F.in(I_CONVW) + l * 3 * MIXW;
#pragma unroll 1
    for (int bt = 0; bt < 3; ++bt) {
        u32x4 ac[2][4], ah[2][4], ab[2][2], ag[2][2]; f32x4 w0[2][2], w1[2][2], w2[2][2];
#pragma unroll
        for (int j = 0; j < 2; ++j) { const int idx = tid_ + 512 * (2 * bt + j), tp = idx / 48, c8 = (idx % 48) * 8, t = t0 + 2 * tp; const bf16_t* pr = P + ((size_t)b * SEQ + t) * INC;
#pragma unroll
            for (int k = 0; k < 4; ++k) { const int tt = t - 2 + k; const bf16_t* p2 = pr + (ptrdiff_t)(tt < 0 ? 0 : k - 2) * INC;
                ac[j][k] = *(const u32x4*)(p2 + A_C + c8); ah[j][k] = *(const u32x4*)(p2 + A_H + c8); }
#pragma unroll
            for (int k = 0; k < 2; ++k) { ab[j][k] = *(const u32x4*)(pr + (size_t)k * INC + A_B + c8); ag[j][k] = *(const u32x4*)(pr + (size_t)k * INC + A_G + c8); }
#pragma unroll
            for (int h = 0; h < 2; ++h) { w0[j][h] = *(const f32x4*)(cw + c8 + 4 * h); w1[j][h] = *(const f32x4*)(cw + MIXW + c8 + 4 * h); w2[j][h] = *(const f32x4*)(cw + 2 * MIXW + c8 + 4 * h); } }
#pragma unroll
        for (int j = 0; j < 2; ++j) { const int idx = tid_ + 512 * (2 * bt + j), tp = idx / 48, c8 = (idx % 48) * 8, t = t0 + 2 * tp;
            f32x4 z[4][2];
#pragma unroll
            for (int k = 0; k < 4; ++k) { const u32x4 a = ac[j][k], h = ah[j][k]; const bool okr = (t - 2 + k) >= 0;
                z[k][0] = (f32x4){bflo(a.x) * bflo(h.x), bfhi(a.x) * bfhi(h.x), bflo(a.y) * bflo(h.y), bfhi(a.y) * bfhi(h.y)};
                z[k][1] = (f32x4){bflo(a.z) * bflo(h.z), bfhi(a.z) * bfhi(h.z), bflo(a.w) * bflo(h.w), bfhi(a.w) * bfhi(h.w)};
                if (!okr) { z[k][0] = (f32x4){0.f, 0.f, 0.f, 0.f}; z[k][1] = z[k][0]; } }
#pragma unroll
            for (int k = 0; k < 2; ++k) { const u32x4 bv = ab[j][k], gv = ag[j][k];
                const f32x4 c0 = w0[j][0] * z[k][0] + w1[j][0] * z[k + 1][0] + w2[j][0] * z[k + 2][0], c1 = w0[j][1] * z[k][1] + w1[j][1] * z[k + 1][1] + w2[j][1] * z[k + 2][1];
                u32x4 o; o.x = pk2(bflo(bv.x) * c0.x * siluf_(bflo(gv.x)), bfhi(bv.x) * c0.y * siluf_(bfhi(gv.x))); o.y = pk2(bflo(bv.y) * c0.z * siluf_(bflo(gv.y)), bfhi(bv.y) * c0.w * siluf_(bfhi(gv.y)));
                o.z = pk2(bflo(bv.z) * c1.x * siluf_(bflo(gv.z)), bfhi(bv.z) * c1.y * siluf_(bfhi(gv.z))); o.w = pk2(bflo(bv.w) * c1.z * siluf_(bflo(gv.w)), bfhi(bv.w) * c1.w * siluf_(bfhi(gv.w)));
                *(u32x4*)(BrA + ((size_t)b * SEQ + t + k) * MIXW + c8) = o; } }
    }
}

__device__ __forceinline__ void prompt_outputs(Frame& F, int l) {
    const int lane_ = F.lane(), tid_ = F.wave * 64 + lane_;
    const bf16_t* P = (const bf16_t*)(F.ws() + WS_P);
    const int gt = F.vcu * NTHR + tid_, GT = F.G * NTHR;
    constexpr int U_SWA = NBAT * 128 * 4 * 8, U_D1 = U_SWA, U_D4 = NBAT * 512 * 4 * 8, U_D16 = NBAT * 2048 * 4 * 8, U_CV = NBAT * 2 * 48;
    constexpr int U_ALL = U_SWA + U_D1 + U_D4 + U_D16 + U_CV;
    for (int e0 = gt; e0 < U_ALL; e0 += 4 * GT) {
        u32x4 v[4], v2[4]; float* dst[4]; bool cv[4];
#pragma unroll
        for (int k = 0; k < 4; ++k) {
            const int e = e0 + k * GT; int r = e < U_ALL ? e : gt; const bf16_t* src; const bf16_t* src2; cv[k] = false; dst[k] = nullptr;
            if (r < U_SWA) { const int c8 = r & 7, hr = r >> 3, h = hr & 1, kv = (hr >> 1) & 1, i = (hr >> 2) & 127, b = hr >> 9;
                src = P + (size_t)(b * SEQ + SEQ - 128 + i) * INC + (kv ? S_V : S_K) + 64 * h + 8 * c8; src2 = src; dst[k] = F.out() + O_SWAP + (size_t)l * NBAT * 128 * 256 + (size_t)hr * 64 + 8 * c8; }
            else if ((r -= U_SWA) < U_D1 + U_D4 + U_D16) {
                int g, W, lg; size_t ob;
                if (r < U_D1) { g = 0; W = 128; lg = 0; ob = O_D1P; } else if ((r -= U_D1) < U_D4) { g = 1; W = 512; lg = 2; ob = O_D4P; } else { r -= U_D4; g = 2; W = 2048; lg = 4; ob = O_D16P; }
                const int c8 = r & 7, hr = r >> 3, j = hr & 1, kv = (hr >> 1) & 1, i = (hr >> 2) % W, b = (hr >> 2) / W;
                const int row = perm_row(b * SEQ + SEQ - W + i, lg);
                src = P + (size_t)row * INC + (kv ? D_V : D_K) + 64 * (2 * g + j) + 8 * c8; src2 = src; dst[k] = F.out() + ob + (size_t)l * NBAT * W * 256 + (size_t)hr * 64 + 8 * c8; }
            else { r -= U_D1 + U_D4 + U_D16; const int c8 = r % 48, i = (r / 48) & 1, b = r / 96; cv[k] = true;
                src = P + (size_t)(b * SEQ + SEQ - 2 + i) * INC + A_C + 8 * c8; src2 = src + (A_H - A_C); dst[k] = F.out() + O_CONVP + ((size_t)(l * NBAT + b) * 2 + i) * MIXW + 8 * c8; }
            if (e >= U_ALL) dst[k] = nullptr;
            v[k] = *(const u32x4*)src; v2[k] = *(const u32x4*)src2;
        }
#pragma unroll
        for (int k = 0; k < 4; ++k) { if (!dst[k]) continue;
            f32x4 o0 = {bflo(v[k].x), bfhi(v[k].x), bflo(v[k].y), bfhi(v[k].y)}, o1 = {bflo(v[k].z), bfhi(v[k].z), bflo(v[k].w), bfhi(v[k].w)};
            if (cv[k]) { o0 *= (f32x4){bflo(v2[k].x), bfhi(v2[k].x), bflo(v2[k].y), bfhi(v2[k].y)}; o1 *= (f32x4){bflo(v2[k].z), bfhi(v2[k].z), bflo(v2[k].w), bfhi(v2[k].w)}; }
            *(f32x4*)dst[k] = o0; *(f32x4*)(dst[k] + 4) = o1; }
    }
}

__device__ __forceinline__ void sample_unit(Frame& F, int l, int b) {
    const bf16_t* P = (const bf16_t*)(F.ws() + WS_P);
    LAS float* pc = (LAS float*)F.lds;
    LAS float* pbuf = (LAS float*)(F.lds + 24576);
    LAS float* obuf = (LAS float*)(F.lds + 32768);
    LAS float* lsb = (LAS float*)(F.lds + 32768 + 4096);
    const int lane = F.lane(), wid = F.wave, tid = wid * 64 + lane; const size_t m = (size_t)MP + b;
    u32x4 prow[2]; { const int v0 = tid, v1 = tid + NTHR; prow[0] = *(const u32x4*)(P + m * INC + 8 * v0); prow[1] = *(const u32x4*)(P + m * INC + 8 * (v1 < INC / 8 ? v1 : v0)); }
    __syncthreads();
#pragma unroll
    for (int k = 0; k < 2; ++k) { const int v = tid + k * NTHR; if (v < INC / 8) { const u32x4 w = prow[k]; LAS float* d = pc + 8 * v;
        *(LAS f32x4*)d = (f32x4){bflo(w.x), bfhi(w.x), bflo(w.y), bfhi(w.y)}; *(LAS f32x4*)(d + 4) = (f32x4){bflo(w.z), bfhi(w.z), bflo(w.w), bfhi(w.w)}; } }
    __syncthreads();
    for (int task = wid; task < 12; task += 8) {
        const bool swa = task < 6; const int hd = swa ? task : task - 6;
        int colQ, colK, colV, n, dil, kvh; const float* cache; float* cout;
        if (swa) { kvh = hd / 3; colQ = S_Q + 64 * hd; colK = S_K + 64 * kvh; colV = S_V + 64 * kvh; n = 128; dil = 1;
            cache = F.in(I_CSWA) + ((size_t)l * DB + b) * 128 * 256; cout = F.out() + O_SWAS + ((size_t)l * DB + b) * 128 * 256; }
        else { const int g = hd >> 1; kvh = hd & 1; colQ = D_Q + 64 * hd; colK = D_K + 64 * hd; colV = D_V + 64 * hd;
            n = g == 0 ? 128 : g == 1 ? 512 : 2048; dil = g == 0 ? 1 : g == 1 ? 4 : 16;
            cache = F.in(g == 0 ? I_CD1 : g == 1 ? I_CD4 : I_CD16) + ((size_t)l * DB + b) * n * 256;
            cout = F.out() + (g == 0 ? O_D1S : g == 1 ? O_D4S : O_D16S) + ((size_t)l * DB + b) * n * 256; }
        f32x4 kx[2][16];
#pragma unroll
        for (int j = 0; j < 2; ++j) { const int kk = lane + 1 + 64 * j; const float* kr = cache + ((size_t)(n - dil * kk) * 4 + kvh) * 64;
#pragma unroll
            for (int d4 = 0; d4 < 16; ++d4) kx[j][d4] = *(const f32x4*)(kr + 4 * d4); }
        float s[2] = {0.f, 0.f};
#pragma unroll
        for (int d4 = 0; d4 < 16; ++d4) { const f32x4 q = *(const LAS f32x4*)(pc + colQ + 4 * d4);
#pragma unroll
            for (int j = 0; j < 2; ++j) s[j] += (kx[j][d4].x * q.x + kx[j][d4].y * q.y) + (kx[j][d4].z * q.z + kx[j][d4].w * q.w); }
        s[0] *= 0.125f; s[1] *= 0.125f;
        float s0; { const float a = pc[colQ + lane] * pc[colK + lane]; s0 = wave_sum(a) * 0.125f; }
        float mx = fmaxf(wave_max(fmaxf(s[0], s[1])), s0); float sk = 0.f;
        if (swa) { sk = F.in(I_SINK)[l * 6 + hd]; mx = fmaxf(mx, sk); }
        const float p0 = __expf(s[0] - mx), p1 = __expf(s[1] - mx), pn = __expf(s0 - mx);
        float den = wave_sum(p0 + p1) + pn; if (swa) den += __expf(sk - mx);
        LAS float* pb = pbuf + wid * 192; pb[lane] = p0; pb[64 + lane] = p1; LDS_WAIT();
        { const int kg = lane >> 4, dq = lane & 15; const float* vb = cache + (size_t)(2 + kvh) * 64 + 4 * dq;
          f32x4 vx[32];
#pragma unroll
          for (int i = 0; i < 32; ++i) vx[i] = *(const f32x4*)(vb + (size_t)(n - dil * (1 + kg + 4 * i)) * 256);
          f32x4 o = (f32x4){0.f, 0.f, 0.f, 0.f};
#pragma unroll
          for (int i = 0; i < 32; ++i) o += vx[i] * pb[kg + 4 * i];
          o.x += __shfl_xor(o.x, 16); o.y += __shfl_xor(o.y, 16); o.z += __shfl_xor(o.z, 16); o.w += __shfl_xor(o.w, 16);
          o.x += __shfl_xor(o.x, 32); o.y += __shfl_xor(o.y, 32); o.z += __shfl_xor(o.z, 32); o.w += __shfl_xor(o.w, 32);
          if (kg == 0) { const f32x4 vn = *(const LAS f32x4*)(pc + colV + 4 * dq); const float id = 1.0f / den;
              *(LAS f32x4*)(obuf + task * 64 + 4 * dq) = (o + vn * pn) * id; } }
        if (!swa && lane == 0) lsb[hd] = mx + __logf(den);
        if (swa ? (hd % 3 == 0) : true) { float* cr = cout + (size_t)(n - 1) * 256; cr[kvh * 64 + lane] = pc[colK + lane]; cr[128 + kvh * 64 + lane] = pc[colV + lane]; }
    }
    __syncthreads();
    if (tid < MIXW) {
        const int c = tid; const size_t lb = (size_t)l * DB + b;
        const float* st = F.in(I_SCONV) + lb * 2 * MIXW; const float pv0 = st[c], pv1 = st[MIXW + c];
        const float* cw = F.in(I_CONVW) + l * 3 * MIXW; const float cw0 = cw[c], cw1 = cw[MIXW + c], cw2 = cw[2 * MIXW + c];
        { const float z = pc[A_C + c] * pc[A_H + c]; const float conv = cw0 * pv0 + cw1 * pv1 + cw2 * z;
          const float y = pc[A_B + c] * conv * siluf_(pc[A_G + c]);
          ((bf16_t*)(F.ws() + WS_BR))[m * MIXW + c] = (bf16_t)(pk2(y, 0.f) & 0xffffu);
          float* co = F.out() + O_CONVS + lb * 2 * MIXW; co[c] = pv1; co[MIXW + c] = z; }
        { const float y = obuf[(c >> 6) * 64 + (c & 63)] * siluf_(pc[S_G + c]); ((bf16_t*)(F.ws() + WS_BR + BR1_BYTES))[m * MIXW + c] = (bf16_t)(pk2(y, 0.f) & 0xffffu); }
        { const int hd = c >> 6, g = hd >> 1, j = hd & 1; const float l0 = lsb[j], l1 = lsb[2 + j], l2 = lsb[4 + j]; const float lm = fmaxf(l0, fmaxf(l1, l2));
          const float e0 = __expf(l0 - lm), e1 = __expf(l1 - lm), e2 = __expf(l2 - lm); const float al = (g == 0 ? e0 : g == 1 ? e1 : e2) / (e0 + e1 + e2);
          const float y = obuf[(6 + hd) * 64 + (c & 63)] * al * siluf_(pc[D_G + c]); ((bf16_t*)(F.ws() + WS_BR + 3 * BR1_BYTES))[m * MIXW + c] = (bf16_t)(pk2(y, 0.f) & 0xffffu); }
    }
    if (wid == 6) {
        const size_t lb = (size_t)l * DB + b; float x[6]; float s = 0.f; float lg[6], lbv[6], w00[6], b0[6];
#pragma unroll
        for (int i = 0; i < 6; ++i) { const int c = lane + 64 * i; lg[i] = F.in(I_LNG)[l * MIXW + c]; lbv[i] = F.in(I_LNB)[l * MIXW + c];
            w00[i] = F.in(I_WSP)[((size_t)l * 6 + i) * 128 * 128]; b0[i] = F.in(I_BSP)[(l * 6 + i) * 128]; }
#pragma unroll
        for (int i = 0; i < 6; ++i) { x[i] = pc[C_V + lane + 64 * i]; s += x[i]; }
        const float mu = wave_sum(s) * (1.0f / MIXW); float q = 0.f;
#pragma unroll
        for (int i = 0; i < 6; ++i) { x[i] -= mu; q += x[i] * x[i]; }
        const float rstd = rsqrtf(wave_sum(q) * (1.0f / MIXW) + EPS);
#pragma unroll
        for (int i = 0; i < 6; ++i) { const int c = lane + 64 * i; const float vn = x[i] * rstd * lg[i] + lbv[i];
            F.out()[O_CHV + lb * MIXW + c] = vn;
            const float y = pc[C_U + c] * (w00[i] * vn + b0[i]) * siluf_(pc[C_G + c]);
            ((bf16_t*)(F.ws() + WS_BR + 2 * BR1_BYTES))[m * MIXW + c] = (bf16_t)(pk2(y, 0.f) & 0xffffu); }
    }
}

__device__ __forceinline__ void mix_phase(Frame& F, int l) {
    const int c = F.vcu;
    bf16_t* BrB = (bf16_t*)(F.ws() + WS_BR + BR1_BYTES); bf16_t* BrD = (bf16_t*)(F.ws() + WS_BR + 3 * BR1_BYTES);
    float* lse = (float*)(F.ws() + WS_LSE);
    for (int k = 0; k < 3; ++k) {
        const int u = c + 256 * k; AttDesc D;
        if (u < 384) {
            const int g = u >> 7, rem = u & 127, b = rem >> 5, blkid = rem & 31, lg = 2 * g, d = 1 << lg, L = SEQ >> lg, bpr = L >> 7, r = blkid / bpr, nb = blkid % bpr;
            D.R0 = b * SEQ + r * L + 128 * nb; D.nb = nb; D.colK = D_K + 128 * g; D.colV = D_V + 128 * g; D.colQ = D_Q + 128 * g; D.colG = D_G + 128 * g; D.qstride = 64;
            D.out = BrD; D.outcol = 128 * g; D.orow0 = b * SEQ + 128 * nb * d + r; D.ostride = d; D.sinks = nullptr; D.lse = lse; D.lsecol = 2 * g;
        } else {
            const int v = u - 384, i = v >> 7, rem = v & 127, b = rem >> 5, nb = rem & 31;
            D.R0 = b * SEQ + 128 * nb; D.nb = nb; D.colK = S_K; D.colV = S_V; D.colQ = S_Q + 64 * i; D.colG = S_G + 64 * i; D.qstride = 192;
            D.out = BrB; D.outcol = 64 * i; D.orow0 = D.R0; D.ostride = 1; D.sinks = F.in(I_SINK) + l * 6 + i; D.lse = nullptr; D.lsecol = 0;
        }
        att_unit(F, D);
    }
    if (c < 128) { const int b = c >> 5, ch = c & 31; spatial_unit(F, l, b * SEQ + 128 * ch); conv_unit(F, l, b, 128 * ch); }
    else sample_unit(F, l, c - 128);
    prompt_outputs(F, l);
}
__device__ __forceinline__ void fin_phase(Frame& F) {
    const int lane_ = F.lane(), tid_ = F.wave * 64 + lane_;
    bf16_t* BrD = (bf16_t*)(F.ws() + WS_BR + 3 * BR1_BYTES); const float* lse = (const float*)(F.ws() + WS_LSE);
    const int gt = F.vcu * NTHR + tid_, GT = F.G * NTHR;
    for (int e0 = gt; e0 < MP * 48; e0 += 3 * GT) {
        u32x4 v[3]; float al[3]; u32x4* pp[3];
#pragma unroll
        for (int k = 0; k < 3; ++k) { const int e = e0 + k * GT; const int row = e / 48, c8 = (e % 48) * 8, hd = c8 >> 6, g = hd >> 1, j = hd & 1;
            const float* lr = lse + (size_t)row * 8; const float l0 = lr[j], l1 = lr[2 + j], l2 = lr[4 + j], lm = fmaxf(l0, fmaxf(l1, l2));
            const float e0_ = __expf(l0 - lm), e1 = __expf(l1 - lm), e2 = __expf(l2 - lm); al[k] = (g == 0 ? e0_ : g == 1 ? e1 : e2) / (e0_ + e1 + e2);
            pp[k] = (u32x4*)(BrD + (size_t)row * MIXW + c8); v[k] = *pp[k]; }
#pragma unroll
        for (int k = 0; k < 3; ++k) { const float a = al[k]; const u32x4 x = v[k]; u32x4 o;
            o.x = pk2(bflo(x.x) * a, bfhi(x.x) * a); o.y = pk2(bflo(x.y) * a, bfhi(x.y) * a); o.z = pk2(bflo(x.z) * a, bfhi(x.z) * a); o.w = pk2(bflo(x.w) * a, bfhi(x.w) * a);
            *pp[k] = o; }
    }
}

__device__ __forceinline__ void thin_g2(Frame& F, int l, int unit) {
    const bf16_t* Br = (const bf16_t*)(F.ws() + WS_BR); const bf16_t* WbT = (const bf16_t*)(F.ws() + WS_WBT + l * WBT_BYTES); const bf16_t* Gt = (const bf16_t*)(F.ws() + WS_G);
    bf16_t* mrg = (bf16_t*)(F.ws() + WS_MRG);
    const int lane = F.lane(), fr = lane & 15, fq = lane >> 4; const size_t row = (size_t)MP + 16 * F.wave + fr; const int col0 = 16 * unit;
    f32x4 mg = (f32x4){0.f, 0.f, 0.f, 0.f};
#pragma unroll
    for (int np = 0; np < 2; ++np) {
        bf16x8 a[2][12], b[2][12]; u32x2 gw[2];
#pragma unroll
        for (int h = 0; h < 2; ++h) { const int n = 2 * np + h;
            const bf16_t* ap = Br + (size_t)n * MPAD * MIXW + row * MIXW + 8 * fq; const bf16_t* bp = WbT + (size_t)n * DM * MIXW + (size_t)(col0 + fr) * MIXW + 8 * fq;
#pragma unroll
            for (int k = 0; k < 12; ++k) { a[h][k] = *(const bf16x8*)(ap + 32 * k); b[h][k] = *(const bf16x8*)(bp + 32 * k); }
            gw[h] = *(const u32x2*)(Gt + row * MRG + n * DM + col0 + 4 * fq); }
#pragma unroll
        for (int h = 0; h < 2; ++h) { f32x4 acc = (f32x4){0.f, 0.f, 0.f, 0.f};
#pragma unroll
            for (int k = 0; k < 12; ++k) acc = __builtin_amdgcn_mfma_f32_16x16x32_bf16(b[h][k], a[h][k], acc, 0, 0, 0);
            mg.x += acc.x * bflo(gw[h].x); mg.y += acc.y * bfhi(gw[h].x); mg.z += acc.z * bflo(gw[h].y); mg.w += acc.w * bfhi(gw[h].y); }
    }
    u32x2 w; w.x = pk2(mg.x, mg.y); w.y = pk2(mg.z, mg.w); *(u32x2*)(mrg + row * DM + col0 + 4 * fq) = w;
}
__device__ __forceinline__ void thin_g3(Frame& F, int l, int unit, const float* xold, float* xnew) {
    const bf16_t* mrg = (const bf16_t*)(F.ws() + WS_MRG); const bf16_t* WoT = (const bf16_t*)(F.ws() + WS_WOT + l * WOT_BYTES);
    bf16_t* xb = (bf16_t*)(F.ws() + WS_XB); float* ssq = (float*)(F.ws() + WS_SSQ);
    const int lane = F.lane(), fr = lane & 15, fq = lane >> 4; const int lr = 16 * F.wave + fr; const size_t row = (size_t)MP + lr; const int col0 = 64 * unit;
    f32x4 acc[4];
#pragma unroll
    for (int c = 0; c < 4; ++c) acc[c] = (f32x4){0.f, 0.f, 0.f, 0.f};
    const bf16_t* ap = mrg + row * DM + 8 * fq; const bf16_t* bp = WoT + (size_t)(col0 + fr) * DM + 8 * fq;
    f32x4 xo[4];
#pragma unroll
    for (int c = 0; c < 4; ++c) xo[c] = *(const f32x4*)(xold + (size_t)lr * DM + col0 + 16 * c + 4 * fq);
#pragma unroll 1
    for (int kb = 0; kb < 4; ++kb) {
        bf16x8 a[8], b[4][8];
#pragma unroll
        for (int k = 0; k < 8; ++k) { a[k] = *(const bf16x8*)(ap + 256 * kb + 32 * k);
#pragma unroll
            for (int c = 0; c < 4; ++c) b[c][k] = *(const bf16x8*)(bp + (size_t)16 * c * DM + 256 * kb + 32 * k); }
#pragma unroll
        for (int k = 0; k < 8; ++k)
#pragma unroll
            for (int c = 0; c < 4; ++c) acc[c] = __builtin_amdgcn_mfma_f32_16x16x32_bf16(b[c][k], a[k], acc[c], 0, 0, 0);
    }
    float sq = 0.f;
#pragma unroll
    for (int c = 0; c < 4; ++c) { const size_t off = (size_t)lr * DM + col0 + 16 * c + 4 * fq; const f32x4 xn = xo[c] + acc[c];
        *(f32x4*)(xnew + off) = xn; u32x2 w; w.x = pk2(xn.x, xn.y); w.y = pk2(xn.z, xn.w); *(u32x2*)(xb + row * DM + col0 + 16 * c + 4 * fq) = w;
        sq += (xn.x * xn.x + xn.y * xn.y) + (xn.z * xn.z + xn.w * xn.w); }
    sq += __shfl_xor(sq, 16); sq += __shfl_xor(sq, 32);
    if (fq == 0) ssq[row * 16 + unit] = sq;
}

__device__ __forceinline__ void final_phase(Frame& F) {
    const int lane_ = F.lane(), tid_ = F.wave * 64 + lane_; (void)tid_;
    const int gw = F.vcu * NWAVES + F.wave, NGW = F.G * NWAVES; const float* ssq = (const float*)(F.ws() + WS_SSQ); const float* fg = F.in(I_FNG);
    f32x4 gv[4];
#pragma unroll
    for (int j = 0; j < 4; ++j) gv[j] = ((const f32x4*)fg)[lane_ + 64 * j];
    for (int m = gw; m < MT; m += NGW) {
        const f32x4* sp = (const f32x4*)(ssq + (size_t)m * 16); const f32x4 a = sp[0], b = sp[1], c = sp[2], d = sp[3];
        const float s = ((a.x + a.y) + (a.z + a.w)) + ((b.x + b.y) + (b.z + b.w)) + ((c.x + c.y) + (c.z + c.w)) + ((d.x + d.y) + (d.z + d.w));
        const float rstd = rsqrtf(s * (1.0f / DM) + EPS);
        f32x4* xr = (f32x4*)(F.out() + (size_t)m * DM);
#pragma unroll
        for (int j = 0; j < 4; ++j) { f32x4 v = xr[lane_ + 64 * j]; v = v * rstd * gv[j]; xr[lane_ + 64 * j] = v; }
    }
}

#ifndef PROBE_REPEAT
#define PROBE_REPEAT -1
#endif
#ifndef PROBE_VAR
#define PROBE_VAR 0
#endif
#ifndef DIAG_MASK
#define DIAG_MASK 0xFFFF
#endif
#define IN(k) ((((DIAG_MASK) >> ((k) > 5 && (k) < 11 ? (k) - 5 : (k))) & 1) && lo <= (k) && (k) < hi)
#define GBAR() flat_barrier(bar, ++bseq)
#define SEAM(k) do { if (IN(k) && IN((k) + 1)) GBAR(); } while (0)
template <int l>
__device__ __forceinline__ void layer_phases(Frame& F, const int lo, const int hi, unsigned* bar, unsigned& bseq) {
        const int pb = 1 + 5 * l;
        for (int rep = 0; rep < ((PROBE_REPEAT == 1 && l == 0) ? 2 : 1); ++rep) { if (rep) GBAR();
        if (IN(pb)) {
            pg8::Gemm g{(const bf16_t*)(F.ws() + WS_XB), (const bf16_t*)(F.ws() + WS_W1T + l * W1T_BYTES), DM, DM, DM, 0, 0};
            SchedG1 S; S.nM = MPAD / 256; S.nN = N1PAD / 256; S.nwg = S.nM * S.nN; S.G = F.G; S.c = (int)blockIdx.x;
            EpiG1 E{(bf16_t*)(F.ws() + WS_P), (bf16_t*)(F.ws() + WS_G), (const float*)(F.ws() + WS_SSQ), (const float*)(F.ws() + WS_COS), (const float*)(F.ws() + WS_SIN)};
            if (PROBE_VAR == 1 && rep == 1) { EpiNull<true> E0; pg8::gemm_phase<EpiNull<true>, SchedG1, true>(F.lds, F.wave, g, S, E0); }
            else pg8::gemm_phase<EpiG1, SchedG1, true>(F.lds, F.wave, g, S, E);
        } }
        SEAM(pb);
        for (int rep = 0; rep < ((PROBE_REPEAT == 2 && l == 0) ? 2 : 1); ++rep) { if (rep) GBAR();
        if (IN(pb + 1)) { mix_phase(F, l); }
        SEAM(pb + 1);
        if (IN(pb + 2)) { fin_phase(F); } }
        SEAM(pb + 2);
        for (int rep = 0; rep < ((PROBE_REPEAT == 4 && l == 0) ? 2 : 1); ++rep) { if (rep) GBAR();
        if (IN(pb + 3)) {
            pg8::Gemm g{(const bf16_t*)(F.ws() + WS_BR), (const bf16_t*)(F.ws() + WS_WBT + l * WBT_BYTES), MIXW, MIXW, MIXW, (size_t)MPAD * MIXW, (size_t)DM * MIXW};
            SchedSub S{F.vcu, F.G, 4, 512};
            EpiG2 E; E.Gt = (const bf16_t*)(F.ws() + WS_G); E.mrg = (bf16_t*)(F.ws() + WS_MRG); E.init();
            if (PROBE_VAR == 1 && rep == 1) { EpiNull<true> E0; pg8::gemm_phase<EpiNull<true>, SchedSub, false, true>(F.lds, F.wave, g, S, E0); }
            else pg8::gemm_phase<EpiG2, SchedSub, false, true>(F.lds, F.wave, g, S, E);
            if (!(PROBE_VAR >= 1 && rep == 1)) for (int u = F.vcu; u < 64; u += F.G) thin_g2(F, l, u);
        } }
        SEAM(pb + 3);
        for (int rep = 0; rep < ((PROBE_REPEAT == 5 && l == 0) ? 2 : 1); ++rep) { if (rep) GBAR();
        if (IN(pb + 4)) {
            const float* xold_p = l == 0 ? F.in(I_XP) : (const float*)(F.ws() + WS_X1);
            const float* xold_s = l == 0 ? F.in(I_XS) : (const float*)(F.ws() + WS_X1) + (size_t)MP * DM;
            float* xnew = l == DEPTH - 1 ? F.out() : (float*)(F.ws() + WS_X1);
            pg8::Gemm g{(const bf16_t*)(F.ws() + WS_MRG), (const bf16_t*)(F.ws() + WS_WOT + l * WOT_BYTES), DM, DM, DM, 0, 0};
            SchedSub S{F.vcu, F.G, 1, 256};
            EpiG3 E{xold_p, xnew, (bf16_t*)(F.ws() + WS_XB), (float*)(F.ws() + WS_SSQ)};
            if (PROBE_VAR == 1 && rep == 1) { EpiNull<false> E0; pg8::gemm_phase<EpiNull<false>, SchedSub, false>(F.lds, F.wave, g, S, E0); }
            else pg8::gemm_phase<EpiG3, SchedSub, false>(F.lds, F.wave, g, S, E);
            if (!(PROBE_VAR >= 1 && rep == 1)) for (int u = F.vcu; u < 16; u += F.G) thin_g3(F, l, u, xold_s, xnew + (size_t)MP * DM);
        } }
        SEAM(pb + 4);
}
constexpr int N_PHASES = 12;
__global__ void __launch_bounds__(NTHR, 2) mk_fwd(Args args) {
    extern __shared__ __attribute__((aligned(16))) unsigned char lds_raw[];
    Frame F;
    F.lds = (LAS unsigned char*)lds_raw;
    F.wave = __builtin_amdgcn_readfirstlane(threadIdx.x >> 6);
    F.G = gridDim.x; { const int bx = blockIdx.x; F.vcu = (F.G % 8 == 0) ? (bx % 8) * (F.G / 8) + bx / 8 : bx; }
    volatile LAS unsigned* MISC = (volatile LAS unsigned*)(F.lds + MISC_OFF);
    for (int u = threadIdx.x; u < (LDS_BYTES - RING_BYTES) / 4; u += NTHR) ((LAS unsigned*)(F.lds + RING_BYTES))[u] = 0u;
    __syncthreads();
    const int lo = args.ph_lo, hi = args.ph_hi;
    const bool one_launch = (hi - lo) > 1;
    unsigned* bar = (unsigned*)(F.ws() + WS_CTL) + CW_BAR; unsigned bseq = 0u; (void)one_launch; (void)MISC;

    if (IN(0)) { p0_prologue(F); if (PROBE_REPEAT == 0) { GBAR(); p0_prologue(F); } }
    SEAM(0);
    if (PROBE_REPEAT == 21) { for (int i = 0; i < 10; ++i) GBAR(); }
    layer_phases<0>(F, lo, hi, bar, bseq);
    layer_phases<1>(F, lo, hi, bar, bseq);
    if (IN(11)) { final_phase(F); }
#undef IN
#undef SEAM
}

#ifndef MK_N_LAUNCHES
#define MK_N_LAUNCHES 1
#endif
extern "C" void kernel_launch(void* const* d_in, const int* in_sizes, int n_in, void* d_out, int out_size, void* d_ws, size_t ws_size, hipStream_t stream) {
    static int grid = 0;
    if (grid == 0) {
        if (n_in != 19 || (size_t)out_size != O_END || ws_size < WS_END) { fprintf(stderr, "kernel_launch: unexpected shapes (n_in %d out %d ws %zu need %zu)\n", n_in, out_size, ws_size, (size_t)WS_END); grid = -1; return; }
        int dev = 0, cus = 0, per_cu = 0;
        if (hipGetDevice(&dev) != hipSuccess || hipDeviceGetAttribute(&cus, hipDeviceAttributeMultiprocessorCount, dev) != hipSuccess) { grid = -1; return; }
        if (hipFuncSetAttribute((const void*)mk_fwd, hipFuncAttributeMaxDynamicSharedMemorySize, LDS_BYTES) != hipSuccess) { fprintf(stderr, "kernel_launch: hipFuncSetAttribute failed\n"); grid = -1; return; }
        if (hipOccupancyMaxActiveBlocksPerMultiprocessor(&per_cu, (const void*)mk_fwd, NTHR, LDS_BYTES) != hipSuccess || per_cu < 1) { fprintf(stderr, "kernel_launch: occupancy query says %d\n", per_cu); }
        (void)hipGetLastError();
        grid = cus;
        if (grid != 256) fprintf(stderr, "kernel_launch: %d CUs (built for 256)\n", grid);
    }
    if (grid < 0) return;
    (void)hipMemsetAsync((char*)d_ws + WS_CTL, 0, CTL_BYTES, stream);
    Args a{};
    for (int i = 0; i < 19; ++i) a.in[i] = (const float*)d_in[i];
    a.out = (float*)d_out; a.ws = (unsigned char*)d_ws;
#if MK_N_LAUNCHES == 1
    a.ph_lo = 0; a.ph_hi = N_PHASES;
    hipLaunchKernelGGL(mk_fwd, dim3(grid), dim3(NTHR), LDS_BYTES, stream, a);
#else
    for (int p = 0; p < N_PHASES; ++p) { a.ph_lo = p; a.ph_hi = p + 1; hipLaunchKernelGGL(mk_fwd, dim3(grid), dim3(NTHR), LDS_BYTES, stream, a); }
#endif
}
```
